# Optimizing an MI355X kernel written in HIP

```python
import math, functools
import jax, jax.numpy as jnp
from jax import lax
import numpy as np

D_MODEL = 2048
BATCH = 8
SEQ = 2048
DEPTH = 1
DEC_BATCH = 128
DEC_SEQ = 4
PAST_LEN = 8192
PAGE_SIZE = 128

N_HEADS = 16
N_KV_HEADS = 4
GROUP = N_HEADS // N_KV_HEADS
HEAD_DIM = 64
WINDOW = 128
ROT_DIM = HEAD_DIM // 4
ROPE_THETA = 500000.0
SWA_Q = N_HEADS * HEAD_DIM
SWA_KV = N_KV_HEADS * HEAD_DIM
GLA_HEADS = 4
GLA_DK_TOTAL = D_MODEL // 2
GLA_DV_TOTAL = D_MODEL
GLA_DK = GLA_DK_TOTAL // GLA_HEADS
GLA_DV = GLA_DV_TOTAL // GLA_HEADS
GLA_GATE_RANK = 16
GLA_GATE_NORM = 16.0
GLA_CHUNK = 16
D_FF = 4 * D_MODEL
EPS = 1e-6
SPLITS = (SWA_Q, SWA_KV, SWA_KV, GLA_DK_TOTAL, GLA_DK_TOTAL, GLA_DV_TOTAL, GLA_DV_TOTAL,
          GLA_GATE_RANK, D_MODEL, D_MODEL)
D_IN = sum(SPLITS)

kernel_name = "hybrid_swa_sink_gla_gated_merge_step"


def rms_norm(x, w):
    xf = x.astype(jnp.float32)
    y = xf * lax.rsqrt(jnp.mean(xf * xf, axis=-1, keepdims=True) + EPS)
    return (y * w.astype(jnp.float32)).astype(x.dtype)


def partial_rope(x, pos):
    half = ROT_DIM // 2
    inv = ROPE_THETA ** (-jnp.arange(half, dtype=jnp.float32) * 2.0 / ROT_DIM)
    ang = pos.astype(jnp.float32)[:, None] * inv[None, :]
    cos = jnp.cos(ang)[:, None, :]
    sin = jnp.sin(ang)[:, None, :]
    xf = x.astype(jnp.float32)
    x1 = xf[..., :half]
    x2 = xf[..., half:ROT_DIM]
    out = jnp.concatenate([x1 * cos - x2 * sin, x2 * cos + x1 * sin, xf[..., ROT_DIM:]], axis=-1)
    return out.astype(x.dtype)


def sink_attend(q, k, v, mask, sink):
    s = jnp.einsum('...qkgd,...skd->...kgqs', q, k, preferred_element_type=jnp.float32) * (HEAD_DIM ** -0.5)
    s = jnp.where(mask, s, -jnp.inf)
    sk = sink.astype(jnp.float32)[:, :, None, None]
    m = jnp.maximum(jnp.max(s, axis=-1, keepdims=True), sk)
    p = jnp.exp(s - m)
    denom = jnp.sum(p, axis=-1, keepdims=True) + jnp.exp(sk - m)
    return jnp.einsum('...kgqs,...skd->...qkgd', p / denom, v.astype(jnp.float32))


def swa_prompt(q, k, v, sink):
    B, T = q.shape[:2]
    nb = T // WINDOW
    qb = q.reshape(B, nb, WINDOW, N_KV_HEADS, GROUP, HEAD_DIM)
    kb = k.reshape(B, nb, WINDOW, N_KV_HEADS, HEAD_DIM)
    vb = v.reshape(B, nb, WINDOW, N_KV_HEADS, HEAD_DIM)
    prev = lambda a: jnp.concatenate([jnp.zeros_like(a[:, :1]), a[:, :-1]], axis=1)
    kc = jnp.concatenate([prev(kb), kb], axis=2)
    vc = jnp.concatenate([prev(vb), vb], axis=2)
    qpos = jnp.arange(T).reshape(nb, WINDOW)
    kpos = jnp.concatenate([qpos - WINDOW, qpos], axis=1)
    diff = qpos[:, :, None] - kpos[:, None, :]
    mask = (diff >= 0) & (diff < WINDOW) & (kpos[:, None, :] >= 0)
    o = sink_attend(qb, kc, vc, mask[None, :, None, None], sink)
    w_keep = min(WINDOW, T)
    return o.reshape(B, T, SWA_Q), (k[:, T - w_keep:], v[:, T - w_keep:])


def swa_sample(ck, cv, q, k, v, sink):
    Bd, S = q.shape[:2]
    Wc = ck.shape[1]
    kall = jnp.concatenate([ck, k.astype(ck.dtype)], axis=1)
    vall = jnp.concatenate([cv, v.astype(cv.dtype)], axis=1)
    qpos = PAST_LEN + jnp.arange(S)
    kpos = PAST_LEN - Wc + jnp.arange(Wc + S)
    diff = qpos[:, None] - kpos[None, :]
    mask = (diff >= 0) & (diff < WINDOW)
    o = sink_attend(q.reshape(Bd, S, N_KV_HEADS, GROUP, HEAD_DIM), kall, vall, mask, sink)
    return o.reshape(Bd, S, SWA_Q), (kall[:, S:], vall[:, S:])


def gla_recurrent(q, k, v, log_a, S0):
    B, T = q.shape[:2]
    L = math.gcd(T, GLA_CHUNK)
    N = T // L
    r = lambda a: a.reshape(B, N, L, *a.shape[2:])
    q, k, v, log_a = r(q), r(k), r(v), r(log_a)
    b = jnp.cumsum(log_a, axis=2)
    b_last = b[:, :, -1:]
    q_i = q * jnp.exp(b)
    k_i = k * jnp.exp(-b)
    k_d = k * jnp.exp(b_last - b)
    causal = jnp.tril(jnp.ones((L, L), dtype=bool))
    A = jnp.where(causal, jnp.einsum('bnlhk,bnmhk->bnhlm', q_i, k_i), 0.0)
    o_intra = jnp.einsum('bnhlm,bnmhv->bnlhv', A, v)
    decay = jnp.exp(b_last[:, :, 0])

    def step(S, xs):
        qc, kc, vc, dc = xs
        o = jnp.einsum('blhk,bhkv->blhv', qc, S)
        S = dc[..., None] * S + jnp.einsum('blhk,blhv->bhkv', kc, vc)
        return S, o

    xs = tuple(jnp.moveaxis(a, 1, 0) for a in (q_i, k_d, v, decay))
    S_fin, o_inter = lax.scan(step, S0.astype(jnp.float32), xs)
    o = o_intra + jnp.moveaxis(o_inter, 0, 1)
    return o.reshape(B, T, GLA_HEADS, GLA_DV), S_fin


def decoder_layer(x, pos, swa_fn, S0, norm1, w_in, w_a2, b_a, sink, gla_norm,
                  p_swa, p_gla, w_o, norm2, w_up, w_down):
    B, T, _ = x.shape
    f32 = jnp.float32
    h = rms_norm(x, norm1)
    z = h @ w_in
    qs, ks, vs, qg, kg, vg, rg, ag, gs, gg = jnp.split(z, np.cumsum(SPLITS)[:-1].tolist(), axis=-1)
    q = partial_rope(qs.reshape(B, T, N_HEADS, HEAD_DIM), pos)
    k = partial_rope(ks.reshape(B, T, N_KV_HEADS, HEAD_DIM), pos)
    v = vs.reshape(B, T, N_KV_HEADS, HEAD_DIM)
    o_swa, swa_state = swa_fn(q, k, v, sink.reshape(N_KV_HEADS, GROUP))
    log_a = jax.nn.log_sigmoid((ag @ w_a2 + b_a).astype(f32)) / GLA_GATE_NORM
    hd = lambda a, d: a.reshape(B, T, GLA_HEADS, d).astype(f32)
    o_g, S_new = gla_recurrent(hd(qg, GLA_DK) * (GLA_DK ** -0.5), hd(kg, GLA_DK), hd(vg, GLA_DV),
                               hd(log_a, GLA_DK), S0)
    o_g = o_g * lax.rsqrt(jnp.mean(o_g * o_g, axis=-1, keepdims=True) + EPS) * gla_norm.astype(f32)
    o_g = (o_g.reshape(B, T, GLA_DV_TOTAL) * jax.nn.silu(rg.astype(f32))).astype(x.dtype)
    y = jax.nn.sigmoid(gs) * (o_swa.astype(x.dtype) @ p_swa) + jax.nn.sigmoid(gg) * (o_g @ p_gla)
    x = x + y @ w_o
    h2 = rms_norm(x, norm2)
    x = x + jnp.square(jax.nn.relu(h2 @ w_up)) @ w_down
    return x, swa_state, S_new


def setup_inputs(seed: int = 0) -> dict:
    key = jax.random.key(seed)
    ks = jax.random.split(key, 20)
    nrm = lambda k, shape, scale: jax.random.normal(k, shape, jnp.float32) * scale
    w_buf = min(WINDOW, PAST_LEN)
    return {
        "x_prompt": nrm(ks[0], (BATCH, SEQ, D_MODEL), 1.0),
        "x_sample": nrm(ks[1], (DEC_BATCH, DEC_SEQ, D_MODEL), 1.0),
        "cache_swa_k": nrm(ks[2], (DEPTH, DEC_BATCH, w_buf, N_KV_HEADS, HEAD_DIM), 1.0),
        "cache_swa_v": nrm(ks[3], (DEPTH, DEC_BATCH, w_buf, N_KV_HEADS, HEAD_DIM), 1.0),
        "state_gla": nrm(ks[4], (DEPTH, DEC_BATCH, GLA_HEADS, GLA_DK, GLA_DV), 1.0),
        "norm1": 1.0 + nrm(ks[5], (DEPTH, D_MODEL), 0.02),
        "w_in": nrm(ks[6], (DEPTH, D_MODEL, D_IN), D_MODEL ** -0.5),
        "w_a2": nrm(ks[7], (DEPTH, GLA_GATE_RANK, GLA_DK_TOTAL), GLA_GATE_RANK ** -0.5),
        "b_a": nrm(ks[8], (DEPTH, GLA_DK_TOTAL), 0.1),
        "sink": nrm(ks[9], (DEPTH, N_HEADS), 0.5),
        "gla_norm": 1.0 + nrm(ks[10], (DEPTH, GLA_DV), 0.02),
        "p_swa": nrm(ks[11], (DEPTH, SWA_Q, D_MODEL), SWA_Q ** -0.5),
        "p_gla": nrm(ks[12], (DEPTH, GLA_DV_TOTAL, D_MODEL), GLA_DV_TOTAL ** -0.5),
        "w_o": nrm(ks[13], (DEPTH, D_MODEL, D_MODEL), D_MODEL ** -0.5),
        "norm2": 1.0 + nrm(ks[14], (DEPTH, D_MODEL), 0.02),
        "w_up": nrm(ks[15], (DEPTH, D_MODEL, D_FF), D_MODEL ** -0.5),
        "w_down": nrm(ks[16], (DEPTH, D_FF, D_MODEL), D_FF ** -0.5),
        "final_norm": 1.0 + nrm(ks[17], (D_MODEL,), 0.02),
    }


def reference(x_prompt, x_sample, cache_swa_k, cache_swa_v, state_gla, norm1, w_in, w_a2, b_a,
              sink, gla_norm, p_swa, p_gla, w_o, norm2, w_up, w_down, final_norm):
    xp, xs = x_prompt, x_sample
    pos_p = jnp.arange(xp.shape[1])
    pos_s = PAST_LEN + jnp.arange(xs.shape[1])
    S0_p = jnp.zeros((xp.shape[0], GLA_HEADS, GLA_DK, GLA_DV), jnp.float32)
    kp, vp, sp, ksn, vsn, ssn = [], [], [], [], [], []
    for l in range(DEPTH):
        lw = (norm1[l], w_in[l], w_a2[l], b_a[l], sink[l], gla_norm[l],
              p_swa[l], p_gla[l], w_o[l], norm2[l], w_up[l], w_down[l])
        xp, (k1, v1), S1 = decoder_layer(xp, pos_p, swa_prompt, S0_p, *lw)
        xs, (k2, v2), S2 = decoder_layer(
            xs, pos_s, functools.partial(swa_sample, cache_swa_k[l], cache_swa_v[l]), state_gla[l], *lw)
        kp.append(k1.astype(cache_swa_k.dtype)); vp.append(v1.astype(cache_swa_v.dtype))
        sp.append(S1.astype(state_gla.dtype))
        ksn.append(k2); vsn.append(v2); ssn.append(S2.astype(state_gla.dtype))
    y_prompt = rms_norm(xp, final_norm)
    y_sample = rms_norm(xs, final_norm)
    return (y_prompt, y_sample, jnp.stack(kp), jnp.stack(vp), jnp.stack(sp),
            jnp.stack(ksn), jnp.stack(vsn), jnp.stack(ssn))
```

```cpp
#include <hip/hip_runtime.h>
#include <hip/hip_cooperative_groups.h>
#include <cstdio>
#include <cstdint>
namespace cg = cooperative_groups;

#define LAS __attribute__((address_space(3)))
typedef unsigned short bf16_t;
typedef short bf16x8 __attribute__((ext_vector_type(8)));
typedef float f32x4 __attribute__((ext_vector_type(4)));
typedef float f32x2 __attribute__((ext_vector_type(2)));
typedef unsigned u32x4 __attribute__((ext_vector_type(4)));
typedef unsigned u32x2 __attribute__((ext_vector_type(2)));

constexpr int DM = 2048, MP = 16384, MS = 512, M = MP + MS, DIN = 11792, DINP = 12032, DFF = 8192, OC = 3072;
constexpr int ZQS = 0, ZKS = 1024, ZVS = 1280, ZQG = 1536, ZKG = 2560, ZVG = 3584, ZRG = 5632, ZGS = 7680, ZGG = 9728, ZAG = 11776;
constexpr float EPS = 1e-6f;
constexpr size_t MiB = 1u << 20;
constexpr size_t WS_SS1 = 0, WS_BAR = 131072, BAR_BYTES = 16384, WS_ROPE = 655360;
constexpr size_t WS_WIN = 1 * MiB, WS_PCAT = 48 * MiB, WS_WO = 60 * MiB, WS_WUP = 68 * MiB, WS_WDN = 100 * MiB, WS_XB = 132 * MiB,
                 WS_Z = 198 * MiB, WS_OCAT = 586 * MiB, WS_Y = 685 * MiB, WS_X1B = 751 * MiB, WS_SS2P = 817 * MiB, WS_SSFP = 820 * MiB, WS_GSSP = 823 * MiB, WS_END = 832 * MiB;
constexpr size_t OUT_YS = 33554432, OUT_KP = 34603008, OUT_VP = 34865152, OUT_SP = 35127296, OUT_KS = 39321600, OUT_VS = 43515904, OUT_SS = 47710208, OUT_END = 114819072;
constexpr int LDS_BYTES = 147456;
constexpr int NPHASE = 9;

struct Args {
    const float *xp, *xs, *ck, *cv, *s0, *norm1, *w_in, *w_a2, *b_a, *sink, *gla_norm, *p_swa, *p_gla, *w_o, *norm2, *w_up, *w_down, *fnorm;
    float* out; unsigned char* ws; int ph_lo, ph_hi;
};

__device__ __forceinline__ unsigned cvt_pk_bf16(float lo, float hi) { unsigned r; asm volatile("v_cvt_pk_bf16_f32 %0, %1, %2" : "=v"(r) : "v"(lo), "v"(hi)); return r; }
__device__ __forceinline__ bf16_t f2bf(float f) { return (bf16_t)(cvt_pk_bf16(f, 0.f) & 0xffffu); }
__device__ __forceinline__ float bf2f(unsigned h) { return __uint_as_float(h << 16); }
__device__ __forceinline__ float bflo(unsigned w) { return __uint_as_float(w << 16); }
__device__ __forceinline__ float bfhi(unsigned w) { return __uint_as_float(w & 0xffff0000u); }
__device__ __forceinline__ float wave_sum(float v) {
#pragma unroll
    for (int o = 1; o < 64; o <<= 1) v += __shfl_xor(v, o);
    return v;
}
__device__ __forceinline__ float wave_max(float v) {
#pragma unroll
    for (int o = 1; o < 64; o <<= 1) v = fmaxf(v, __shfl_xor(v, o));
    return v;
}
__device__ __forceinline__ float sigmoidf_(float x) { return 1.f / (1.f + __expf(-x)); }
__device__ __forceinline__ float sum32(const float* p) {
    f32x4 a = *(const f32x4*)p;
#pragma unroll
    for (int i = 1; i < 8; ++i) a += *(const f32x4*)(p + 4 * i);
    return (a[0] + a[1]) + (a[2] + a[3]);
}
#define MFMA_SETTLE1(a) asm volatile("s_nop 15\n\ts_nop 15" : "+v"(a))
#define MFMA_SETTLE4(a, b, c, d) asm volatile("s_nop 15\n\ts_nop 15" : "+v"(a), "+v"(b), "+v"(c), "+v"(d))
#define MFMA_SETTLE8(a, b, c, d, e, f, g, h) asm volatile("s_nop 15\n\ts_nop 15" : "+v"(a), "+v"(b), "+v"(c), "+v"(d), "+v"(e), "+v"(f), "+v"(g), "+v"(h))
#define LBAR() asm volatile("s_waitcnt lgkmcnt(0)\n\ts_barrier" ::: "memory")
#define LDS_WAIT() asm volatile("s_waitcnt lgkmcnt(0)" ::: "memory")

namespace pg8 {
constexpr int BM = 256, BK = 64, HALF = 128, HTB = HALF * BK * 2, STAGE_BYTES = 8 * HTB, NXCD = 8, WGM = 8;
__host__ __device__ __forceinline__ int lds_byte(int r, int c) { const int st = (r >> 4) * 2 + (c >> 5), rr = r & 15, cc = c & 31, ob = rr * 64 + cc * 2; return st * 1024 + (ob ^ (((ob >> 9) & 1) << 5)); }
__host__ __device__ __forceinline__ void stage_rc(int b, int& R, int& C) { const int st = b / 1024, sb = b % 1024, swz = sb ^ (((sb >> 9) & 1) << 5); R = (st >> 1) * 16 + swz / 64; C = (st & 1) * 32 + (swz % 64) / 2; }
__host__ __device__ __forceinline__ int perm32(int rho) { const int n = rho >> 4, i = rho & 15; return 8 * (i >> 2) + 4 * n + (i & 3); }
struct Unit { int pm, pn; };
struct Gemm { const bf16_t* A; const bf16_t* Bt; int M, N, K, lda, ldb; };
struct StaticOrder {
    int nM, nN, nwg, G, c;
    __host__ __device__ void init(int M_, int N_, int G_, int c_) { nM = M_ / BM; nN = N_ / BM; nwg = nM * nN; G = G_; c = c_; }
    __host__ __device__ bool next(int i, Unit& u) const {
        const long L = (long)i * G + c; if (L >= nwg) return false;
        int wgid = (int)L; { const int q = nwg / NXCD, r = nwg % NXCD, xcd = wgid % NXCD, off = wgid / NXCD; wgid = (xcd < r ? xcd * (q + 1) : r * (q + 1) + (xcd - r) * q) + off; }
        const int nig = WGM * nN, gid = wgid / nig, fm = gid * WGM, gsz = (nM - fm) < WGM ? (nM - fm) : WGM;
        u.pm = fm + ((wgid % nig) % gsz); u.pn = (wgid % nig) / gsz; return true;
    }
};

template <class Epi, class Sched>
__device__ __forceinline__ void gemm_phase(LAS unsigned char* lds, const Gemm g, const Sched& S, const Epi& E) {
    const int tid = threadIdx.x, wid = __builtin_amdgcn_readfirstlane(tid >> 6), lane = tid & 63, wr = wid >> 2, wc = wid & 3, fr = lane & 15, fq = lane >> 4;
    const int nt = g.K / BK;
    unsigned voffA[2], voffB[2];
#pragma unroll
    for (int i = 0; i < 2; ++i) { int R, C; stage_rc(tid * 16 + i * 8192, R, C); const int Rb = Epi::PERM ? ((R & ~31) + perm32(R & 31)) : R;
        voffA[i] = (unsigned)(R * g.lda + C) * 2u; voffB[i] = (unsigned)(Rb * g.ldb + C) * 2u; }
    const size_t kstep = (size_t)(BK * 2);
    const size_t hstepA = (size_t)HALF * g.lda * 2, hstepB = (size_t)HALF * g.ldb * 2;
    const size_t tstepA = 2 * hstepA, tstepB = 2 * hstepB;
    const unsigned ldsw = (unsigned)wid * 1024u;
    const int aoff = lds_byte(wr * 64 + fr, fq * 8), boff = lds_byte(wc * 32 + fr, fq * 8);
#define PG8_SA(b, h) (((b) * 2 + (h)) * HTB)
#define PG8_SB(b, h) ((4 + (b) * 2 + (h)) * HTB)
#define PG8_STAGE(bufoff, gbase, voff) do { _Pragma("unroll") for (int _i = 0; _i < 2; ++_i) \
        __builtin_amdgcn_global_load_lds((const unsigned*)((const char*)(gbase) + (voff)[_i]), (LAS unsigned*)(lds + (bufoff) + ldsw + _i * 8192), 16, 0, 0); } while (0)
#define PG8_LDA(dst, b, h) do { _Pragma("unroll") for (int m = 0; m < 4; ++m) _Pragma("unroll") for (int k = 0; k < 2; ++k) dst[m][k] = *(const LAS bf16x8*)(lds + PG8_SA(b, h) + aoff + m * 2048 + k * 1024); } while (0)
#define PG8_LDB(dst, b, h) do { _Pragma("unroll") for (int n = 0; n < 2; ++n) _Pragma("unroll") for (int k = 0; k < 2; ++k) dst[n][k] = *(const LAS bf16x8*)(lds + PG8_SB(b, h) + boff + n * 2048 + k * 1024); } while (0)
#define PG8_MMA(ai, bj, At, Bt) do { __builtin_amdgcn_s_setprio(1); _Pragma("unroll") for (int m = 0; m < 4; ++m) _Pragma("unroll") for (int n = 0; n < 2; ++n) _Pragma("unroll") for (int k = 0; k < 2; ++k) \
        acc[ai][bj][m][n] = __builtin_amdgcn_mfma_f32_16x16x32_bf16(Bt[n][k], At[m][k], acc[ai][bj][m][n], 0, 0, 0); __builtin_amdgcn_s_setprio(0); } while (0)
#define PG8_WAIT_V(n) asm volatile("s_waitcnt vmcnt(" #n ")" ::: "memory")
#define PG8_WAIT_L(n) asm volatile("s_waitcnt lgkmcnt(" #n ")" ::: "memory")
#define PG8_BAR __builtin_amdgcn_s_barrier()
#define PG8_SCHED __builtin_amdgcn_sched_barrier(0)
    Unit cur, nxt; int ui = 0;
    if (!S.next(0, cur)) return;
    f32x4 acc[2][2][4][2];
#pragma unroll
    for (int a = 0; a < 2; ++a)
#pragma unroll
        for (int b = 0; b < 2; ++b)
#pragma unroll
            for (int m = 0; m < 4; ++m)
#pragma unroll
                for (int n = 0; n < 2; ++n) acc[a][b][m][n] = (f32x4){0.f, 0.f, 0.f, 0.f};
    bf16x8 At[4][2], B0[2][2], B1[2][2];
    const char* cA = (const char*)g.A + (size_t)cur.pm * tstepA; const char* cB = (const char*)g.Bt + (size_t)cur.pn * tstepB;
    PG8_STAGE(PG8_SB(0, 0), cB, voffB); PG8_STAGE(PG8_SB(0, 1), cB + hstepB, voffB); PG8_STAGE(PG8_SA(0, 0), cA, voffA); PG8_STAGE(PG8_SA(0, 1), cA + hstepA, voffA);
    if (wr == 1) PG8_BAR;
    PG8_WAIT_V(2); PG8_BAR;
    PG8_STAGE(PG8_SB(1, 0), cB + kstep, voffB); PG8_STAGE(PG8_SA(1, 0), cA + kstep, voffA); PG8_STAGE(PG8_SB(1, 1), cB + hstepB + kstep, voffB);
    PG8_WAIT_V(6); PG8_BAR;
    for (;;) {
        const bool has_next = S.next(ui + 1, nxt);
        const char* nA = has_next ? (const char*)g.A + (size_t)nxt.pm * tstepA : cA; const char* nB = has_next ? (const char*)g.Bt + (size_t)nxt.pn * tstepB : cB;
        for (int t = 0; t < nt; t += 2) {
            const bool last = (t == nt - 2);
            const char* a1 = cA + (size_t)(t + 1) * kstep;
            const char* a2 = last ? nA : cA + (size_t)(t + 2) * kstep; const char* b2 = last ? nB : cB + (size_t)(t + 2) * kstep;
            const char* a3 = a2 + kstep; const char* b3 = b2 + kstep;
            PG8_LDB(B0, 0, 0); PG8_LDB(B1, 0, 1); PG8_SCHED; PG8_LDA(At, 0, 0); PG8_STAGE(PG8_SA(1, 1), a1 + hstepA, voffA);
            PG8_WAIT_V(8); PG8_WAIT_L(0); PG8_BAR; PG8_MMA(0, 0, At, B0); PG8_MMA(0, 1, At, B1); PG8_BAR; PG8_SCHED;
            PG8_LDA(At, 0, 1); PG8_STAGE(PG8_SB(0, 0), b2, voffB); PG8_STAGE(PG8_SB(0, 1), b2 + hstepB, voffB); PG8_STAGE(PG8_SA(0, 0), a2, voffA);
            PG8_WAIT_V(8); PG8_WAIT_L(0); PG8_BAR; PG8_MMA(1, 0, At, B0); PG8_MMA(1, 1, At, B1); PG8_BAR; PG8_SCHED;
            PG8_LDB(B0, 1, 0); PG8_LDB(B1, 1, 1); PG8_SCHED; PG8_LDA(At, 1, 0); PG8_STAGE(PG8_SA(0, 1), a2 + hstepA, voffA);
            PG8_WAIT_V(8); PG8_WAIT_L(0); PG8_BAR; PG8_MMA(0, 0, At, B0); PG8_MMA(0, 1, At, B1); PG8_BAR; PG8_SCHED;
            PG8_LDA(At, 1, 1); PG8_STAGE(PG8_SB(1, 0), b3, voffB); PG8_STAGE(PG8_SB(1, 1), b3 + hstepB, voffB); PG8_STAGE(PG8_SA(1, 0), a3, voffA);
            PG8_WAIT_V(8); PG8_WAIT_L(0); PG8_BAR; PG8_MMA(1, 0, At, B0); PG8_MMA(1, 1, At, B1); PG8_BAR; PG8_SCHED;
        }
        if (wr == 0) PG8_BAR;
        E(acc, cur, wr, wc, fr, fq);
        if (!has_next) break;
#pragma unroll
        for (int a = 0; a < 2; ++a)
#pragma unroll
            for (int b = 0; b < 2; ++b)
#pragma unroll
                for (int m = 0; m < 4; ++m)
#pragma unroll
                    for (int n = 0; n < 2; ++n) acc[a][b][m][n] = (f32x4){0.f, 0.f, 0.f, 0.f};
        cur = nxt; cA = nA; cB = nB; ++ui;
        if (wr == 1) PG8_BAR;
    }
    PG8_WAIT_V(0);
    PG8_BAR;
#undef PG8_SA
#undef PG8_SB
#undef PG8_STAGE
#undef PG8_LDA
#undef PG8_LDB
#undef PG8_MMA
#undef PG8_WAIT_V
#undef PG8_WAIT_L
#undef PG8_BAR
#undef PG8_SCHED
}

template <int ACT  > struct EpiScaleBf16 {
    static constexpr bool PERM = true;
    bf16_t* O; int ldc; const float* ss;
    __device__ __forceinline__ void operator()(const f32x4 (&acc)[2][2][4][2], const Unit& u, int wr, int wc, int fr, int fq) const {
        const int row0 = u.pm * BM + wr * 64 + fr, col0 = u.pn * BM + wc * 32 + 8 * fq;
#pragma unroll
        for (int ai = 0; ai < 2; ++ai)
#pragma unroll
            for (int m = 0; m < 4; ++m) { const int row = row0 + ai * HALF + m * 16; const float rs = ACT == 1 ? ss[row] : 1.0f;
                bf16_t* rowp = O + (size_t)row * ldc + col0;
#pragma unroll
                for (int bj = 0; bj < 2; ++bj) { f32x4 v0 = acc[ai][bj][m][0] * rs, v1 = acc[ai][bj][m][1] * rs;
                    if (ACT == 1) {
#pragma unroll
                        for (int e = 0; e < 4; ++e) { const float a0 = fmaxf(v0[e], 0.f), a1 = fmaxf(v1[e], 0.f); v0[e] = a0 * a0; v1[e] = a1 * a1; } }
                    u32x4 w; w.x = cvt_pk_bf16(v0[0], v0[1]); w.y = cvt_pk_bf16(v0[2], v0[3]); w.z = cvt_pk_bf16(v1[0], v1[1]); w.w = cvt_pk_bf16(v1[2], v1[3]);
                    *(u32x4*)(rowp + bj * HALF) = w; } }
    }
};
__device__ __forceinline__ void unpack8(const u32x4& w, float (&f)[8]) { f[0] = bflo(w.x); f[1] = bfhi(w.x); f[2] = bflo(w.y); f[3] = bfhi(w.y); f[4] = bflo(w.z); f[5] = bfhi(w.z); f[6] = bflo(w.w); f[7] = bfhi(w.w); }
struct EpiMergeA {
    static constexpr bool PERM = true;
    bf16_t* T; const bf16_t* gate; int ldg;
    __device__ __forceinline__ void operator()(const f32x4 (&acc)[2][2][4][2], const Unit& u, int wr, int wc, int fr, int fq) const {
        const int row0 = u.pm * BM + wr * 64 + fr, col0 = u.pn * BM + wc * 32 + 8 * fq;
#pragma unroll
        for (int ai = 0; ai < 2; ++ai) { u32x4 gw[4][2];
#pragma unroll
            for (int m = 0; m < 4; ++m)
#pragma unroll
                for (int bj = 0; bj < 2; ++bj) gw[m][bj] = *(const u32x4*)(gate + (size_t)(row0 + ai * HALF + m * 16) * ldg + col0 + bj * HALF);
#pragma unroll
            for (int m = 0; m < 4; ++m)
#pragma unroll
                for (int bj = 0; bj < 2; ++bj) { float g[8]; unpack8(gw[m][bj], g); const f32x4 a0 = acc[ai][bj][m][0], a1 = acc[ai][bj][m][1]; float o[8];
#pragma unroll
                    for (int e = 0; e < 4; ++e) { o[e] = a0[e] * sigmoidf_(g[e]); o[4 + e] = a1[e] * sigmoidf_(g[4 + e]); }
                    *(u32x4*)(T + (size_t)(row0 + ai * HALF + m * 16) * DM + col0 + bj * HALF) = (u32x4){cvt_pk_bf16(o[0], o[1]), cvt_pk_bf16(o[2], o[3]), cvt_pk_bf16(o[4], o[5]), cvt_pk_bf16(o[6], o[7])}; } }
    }
};
struct EpiMergeB {
    static constexpr bool PERM = true;
    const bf16_t* T; const bf16_t* gate; int ldg; bf16_t* Y;
    __device__ __forceinline__ void operator()(const f32x4 (&acc)[2][2][4][2], const Unit& u, int wr, int wc, int fr, int fq) const {
        const int row0 = u.pm * BM + wr * 64 + fr, col0 = u.pn * BM + wc * 32 + 8 * fq;
#pragma unroll
        for (int ai = 0; ai < 2; ++ai) { u32x4 gw[4][2], tw[4][2];
#pragma unroll
            for (int m = 0; m < 4; ++m)
#pragma unroll
                for (int bj = 0; bj < 2; ++bj) { const size_t r = (size_t)(row0 + ai * HALF + m * 16); gw[m][bj] = *(const u32x4*)(gate + r * ldg + col0 + bj * HALF); tw[m][bj] = *(const u32x4*)(T + r * DM + col0 + bj * HALF); }
#pragma unroll
            for (int m = 0; m < 4; ++m)
#pragma unroll
                for (int bj = 0; bj < 2; ++bj) { float g[8], t[8]; unpack8(gw[m][bj], g); unpack8(tw[m][bj], t); const f32x4 a0 = acc[ai][bj][m][0], a1 = acc[ai][bj][m][1]; float o[8];
#pragma unroll
                    for (int e = 0; e < 4; ++e) { o[e] = t[e] + a0[e] * sigmoidf_(g[e]); o[4 + e] = t[4 + e] + a1[e] * sigmoidf_(g[4 + e]); }
                    *(u32x4*)(Y + (size_t)(row0 + ai * HALF + m * 16) * DM + col0 + bj * HALF) = (u32x4){cvt_pk_bf16(o[0], o[1]), cvt_pk_bf16(o[2], o[3]), cvt_pk_bf16(o[4], o[5]), cvt_pk_bf16(o[6], o[7])}; } }
    }
};
template <bool WB> struct EpiResid {
    static constexpr bool PERM = false;
    const float* basep; const float* bases; float* out; bf16_t* ob; float* ss;
    __device__ __forceinline__ void operator()(const f32x4 (&acc)[2][2][4][2], const Unit& u, int wr, int wc, int fr, int fq) const {
        const int row0 = u.pm * BM + wr * 64 + fr, col0 = u.pn * BM + wc * 32 + 4 * fq;
#pragma unroll
        for (int ai = 0; ai < 2; ++ai)
#pragma unroll
            for (int mp = 0; mp < 2; ++mp) {
                f32x4 bv[2][4];
#pragma unroll
                for (int mm = 0; mm < 2; ++mm) { const int row = row0 + ai * HALF + (mp * 2 + mm) * 16; const float* br = row < MP ? basep + (size_t)row * DM : bases + (size_t)(row - MP) * DM;
#pragma unroll
                    for (int bj = 0; bj < 2; ++bj)
#pragma unroll
                        for (int n = 0; n < 2; ++n) bv[mm][bj * 2 + n] = *(const f32x4*)(br + col0 + bj * HALF + n * 16); }
#pragma unroll
                for (int mm = 0; mm < 2; ++mm) { const int m = mp * 2 + mm; const int row = row0 + ai * HALF + m * 16; float s = 0.f;
#pragma unroll
                    for (int bj = 0; bj < 2; ++bj)
#pragma unroll
                        for (int n = 0; n < 2; ++n) { const int col = col0 + bj * HALF + n * 16; const f32x4 o = bv[mm][bj * 2 + n] + acc[ai][bj][m][n];
                            s += (o[0] * o[0] + o[1] * o[1]) + (o[2] * o[2] + o[3] * o[3]);
                            *(f32x4*)(out + (size_t)row * DM + col) = o;
                            if (WB) { u32x2 w; w.x = cvt_pk_bf16(o[0], o[1]); w.y = cvt_pk_bf16(o[2], o[3]); *(u32x2*)(ob + (size_t)row * DM + col) = w; } }
                    s += __shfl_xor(s, 16); s += __shfl_xor(s, 32);
                    if (fq == 0) ss[(size_t)row * 32 + u.pn * 4 + wc] = s; } }
    }
};
template <int MODE> struct EpiResidB {
    static constexpr bool PERM = true;
    const float* basep; const float* bases; const bf16_t* baseb; bf16_t* ob; float* ss;
    __device__ __forceinline__ void operator()(const f32x4 (&acc)[2][2][4][2], const Unit& u, int wr, int wc, int fr, int fq) const {
        const int row0 = u.pm * BM + wr * 64 + fr, col0 = u.pn * BM + wc * 32 + 8 * fq;
#pragma unroll
        for (int ai = 0; ai < 2; ++ai) {
            f32x4 bf[MODE == 0 ? 4 : 1][2][2]; u32x4 bb[MODE == 1 ? 4 : 1][2];
#pragma unroll
            for (int m = 0; m < 4; ++m) { const int row = row0 + ai * HALF + m * 16;
                if (MODE == 0) { const float* br = row < MP ? basep + (size_t)row * DM : bases + (size_t)(row - MP) * DM;
#pragma unroll
                    for (int bj = 0; bj < 2; ++bj) { bf[MODE == 0 ? m : 0][bj][0] = *(const f32x4*)(br + col0 + bj * HALF); bf[MODE == 0 ? m : 0][bj][1] = *(const f32x4*)(br + col0 + bj * HALF + 4); } }
                else {
#pragma unroll
                    for (int bj = 0; bj < 2; ++bj) bb[MODE == 1 ? m : 0][bj] = *(const u32x4*)(baseb + (size_t)row * DM + col0 + bj * HALF); } }
#pragma unroll
            for (int m = 0; m < 4; ++m) { const int row = row0 + ai * HALF + m * 16; float s = 0.f;
#pragma unroll
                for (int bj = 0; bj < 2; ++bj) { float o[8];
                    if (MODE == 0) { const f32x4 b0 = bf[MODE == 0 ? m : 0][bj][0], b1 = bf[MODE == 0 ? m : 0][bj][1];
#pragma unroll
                        for (int e = 0; e < 4; ++e) { o[e] = b0[e] + acc[ai][bj][m][0][e]; o[4 + e] = b1[e] + acc[ai][bj][m][1][e]; } }
                    else { float t[8]; unpack8(bb[MODE == 1 ? m : 0][bj], t);
#pragma unroll
                        for (int e = 0; e < 4; ++e) { o[e] = t[e] + acc[ai][bj][m][0][e]; o[4 + e] = t[4 + e] + acc[ai][bj][m][1][e]; } }
#pragma unroll
                    for (int e = 0; e < 8; ++e) s += o[e] * o[e];
                    *(u32x4*)(ob + (size_t)row * DM + col0 + bj * HALF) = (u32x4){cvt_pk_bf16(o[0], o[1]), cvt_pk_bf16(o[2], o[3]), cvt_pk_bf16(o[4], o[5]), cvt_pk_bf16(o[6], o[7])}; }
                s += __shfl_xor(s, 16); s += __shfl_xor(s, 32);
                if (fq == 0) ss[(size_t)row * 32 + u.pn * 4 + wc] = s; } }
    }
};
}

template <int MODE  >
__device__ __forceinline__ void transpose_item(const float* W, int K, int N, bf16_t* WT, int ldt, int koff, const float* ks, float* scr, int item, int lane) {
    const int nblk = (N + 31) / 32, kb = item / nblk, nb = item % nblk, k0 = 64 * kb, n0 = 32 * nb;
    const int nn = n0 + (lane & 31);
    float v[32]; const float* wp = W + (size_t)(k0 + (lane >> 5)) * N + nn; const bool nok = nn < N;
#pragma unroll
    for (int i = 0; i < 32; ++i) v[i] = nok ? wp[(size_t)(2 * i) * N] : 0.f;
#pragma unroll
    for (int i = 0; i < 32; ++i) { const int kk = 2 * i + (lane >> 5); float x = v[i]; if (MODE != 0) x *= ks[k0 + kk]; scr[kk * 33 + (lane & 31)] = x; }
    LDS_WAIT(); asm volatile("" ::: "memory");
    const int c = lane & 7;
#pragma unroll
    for (int j = 0; j < 4; ++j) { const int nl = (lane >> 3) + 8 * j, n = n0 + nl; const float* s = scr + (8 * c) * 33 + nl;
        u32x4 o; o.x = cvt_pk_bf16(s[0 * 33], s[1 * 33]); o.y = cvt_pk_bf16(s[2 * 33], s[3 * 33]); o.z = cvt_pk_bf16(s[4 * 33], s[5 * 33]); o.w = cvt_pk_bf16(s[6 * 33], s[7 * 33]);
        int dst = n; if (MODE == 1) dst = n < 7680 ? n : (n < 7696 ? ZAG + (n - 7680) : n - 16);
        if (n < N) *(u32x4*)(WT + (size_t)dst * ldt + koff + k0 + 8 * c) = o; }
    LDS_WAIT(); asm volatile("" ::: "memory");
}

__device__ __forceinline__ void phase0(const Args& a, unsigned char* lds, int tid) {
    const int lane = tid & 63, wave = tid >> 6, G = gridDim.x;
    const int gw = blockIdx.x * 8 + wave, NGW = G * 8, gt = blockIdx.x * 512 + tid, GT = G * 512;
    float* scr = (float*)(lds + wave * 8704);
    unsigned char* ws = a.ws;
    bf16_t* WIN = (bf16_t*)(ws + WS_WIN); bf16_t* PCAT = (bf16_t*)(ws + WS_PCAT); bf16_t* WO = (bf16_t*)(ws + WS_WO); bf16_t* WUP = (bf16_t*)(ws + WS_WUP); bf16_t* WDN = (bf16_t*)(ws + WS_WDN);
    constexpr int I_IN = 32 * 369, I_PS = 16 * 64, I_PG = 32 * 64, I_WO = 32 * 64, I_UP = 32 * 256, I_DN = 128 * 64;
    constexpr int NIT = I_IN + I_PS + I_PG + I_WO + I_UP + I_DN;
    for (int it = gw; it < NIT; it += NGW) {
        int r = it;
        if (r < I_IN) { transpose_item<1>(a.w_in, DM, DIN, WIN, DM, 0, a.norm1, scr, r, lane); continue; } r -= I_IN;
        if (r < I_PS) { transpose_item<0>(a.p_swa, 1024, DM, PCAT, OC, 0, nullptr, scr, r, lane); continue; } r -= I_PS;
        if (r < I_PG) { transpose_item<0>(a.p_gla, DM, DM, PCAT, OC, 1024, nullptr, scr, r, lane); continue; } r -= I_PG;
        if (r < I_WO) { transpose_item<0>(a.w_o, DM, DM, WO, DM, 0, nullptr, scr, r, lane); continue; } r -= I_WO;
        if (r < I_UP) { transpose_item<2>(a.w_up, DM, DFF, WUP, DM, 0, a.norm2, scr, r, lane); continue; } r -= I_UP;
        transpose_item<0>(a.w_down, DFF, DM, WDN, DFF, 0, nullptr, scr, r, lane);
    }
    float* SS1 = (float*)(ws + WS_SS1); bf16_t* XB = (bf16_t*)(ws + WS_XB);
    for (int m = gw; m < M; m += NGW) {
        const float* xr = m < MP ? a.xp + (size_t)m * DM : a.xs + (size_t)(m - MP) * DM;
        f32x4 v[8]; float s = 0.f;
#pragma unroll
        for (int j = 0; j < 8; ++j) { v[j] = ((const f32x4*)xr)[lane + 64 * j]; s += (v[j][0] * v[j][0] + v[j][1] * v[j][1]) + (v[j][2] * v[j][2] + v[j][3] * v[j][3]); }
        s = wave_sum(s); const float rs1 = rsqrtf(s * (1.0f / DM) + EPS);
        u32x2* o = (u32x2*)(XB + (size_t)m * DM);
#pragma unroll
        for (int j = 0; j < 8; ++j) { u32x2 w; w.x = cvt_pk_bf16(v[j][0] * rs1, v[j][1] * rs1); w.y = cvt_pk_bf16(v[j][2] * rs1, v[j][3] * rs1); o[lane + 64 * j] = w; }
    }
    { u32x4* p = (u32x4*)(WIN + (size_t)DIN * DM); for (int i = gt; i < (DINP - DIN) * DM * 2 / 16; i += GT) p[i] = (u32x4){0u, 0u, 0u, 0u}; }
    { f32x2* R = (f32x2*)(ws + WS_ROPE);
      for (int i = gt; i < 2052 * 8; i += GT) { const int p = i >> 3, e = i & 7; const int pos = p < 2048 ? p : 8192 + (p - 2048);
          const float inv = exp2f(-(float)e * 2.3664460711655217f); const float ang = (float)pos * inv; float sn, cs; sincosf(ang, &sn, &cs); R[i] = (f32x2){cs, sn}; } }
}

__device__ __forceinline__ float logsig16(float g) { return (fminf(g, 0.f) - __logf(1.f + __expf(-fabsf(g)))) * 0.0625f; }

constexpr size_t WS_QIG = WS_Y, WS_KDG = WS_Y + 32 * MiB, WS_AMG = WS_Y + 64 * MiB, WS_DECG = WS_Y + 68 * MiB;
__device__ __forceinline__ void gla_pre_items(const Args& a, unsigned char* lds, int first, int count, int tid) {
    const int lane = tid & 63, wave = tid >> 6, r16 = lane & 15, q4 = lane >> 4;
    unsigned char* QI = lds; unsigned char* KI = lds + 16896; unsigned char* AGB = lds + 95744; float* LA = (float*)(lds + 99328);
    const bf16_t* Z = (const bf16_t*)(a.ws + WS_Z);
    bf16_t* QIg = (bf16_t*)(a.ws + WS_QIG); bf16_t* KDg = (bf16_t*)(a.ws + WS_KDG); bf16_t* AMg = (bf16_t*)(a.ws + WS_AMG); float* DECg = (float*)(a.ws + WS_DECG);
    const int kcol = tid & 255, half = tid >> 8;
    u32x4 rq[2], rk[2], rag = (u32x4){0u, 0u, 0u, 0u};
#define PRE_LOAD(item_) do { const int bh_ = (item_) >> 6, n_ = (item_) & 63, h_ = bh_ & 3; const size_t r0_ = (size_t)(bh_ >> 2) * 2048 + (size_t)n_ * 32; _Pragma("unroll") for (int i_ = 0; i_ < 2; ++i_) { const int ch_ = tid + i_ * 512, rr_ = ch_ >> 5, cc_ = ch_ & 31; \
        rq[i_] = *(const u32x4*)(Z + (r0_ + rr_) * DINP + ZQG + h_ * 256 + cc_ * 8); rk[i_] = *(const u32x4*)(Z + (r0_ + rr_) * DINP + ZKG + h_ * 256 + cc_ * 8); } \
        if (tid < 64) rag = *(const u32x4*)(Z + (r0_ + (tid >> 1)) * DINP + ZAG + (tid & 1) * 8); } while (0)
    PRE_LOAD(first);
    for (int it = 0; it < count; ++it) {
        const int item = first + it, h = (item >> 6) & 3;
        bf16x8 wfr[2]; float bak[2];
#pragma unroll
        for (int t2 = 0; t2 < 2; ++t2) { const int kc = h * 256 + (wave * 2 + t2) * 16 + r16; bak[t2] = a.b_a[kc]; unsigned pk[4];
#pragma unroll
            for (int i = 0; i < 8; i += 2) { float w2[2];
#pragma unroll
                for (int e = 0; e < 2; ++e) { const int r = (q4 & 1) * 8 + i + e; const float wf = a.w_a2[r * 1024 + kc]; const float whi = bf2f(f2bf(wf)); w2[e] = (q4 < 2) ? whi : (wf - whi); }
                pk[i >> 1] = cvt_pk_bf16(w2[0], w2[1]); }
            wfr[t2] = __builtin_bit_cast(bf16x8, (u32x4){pk[0], pk[1], pk[2], pk[3]}); }
#pragma unroll
        for (int i = 0; i < 2; ++i) { const int ch = tid + i * 512, rr = ch >> 5, cc = ch & 31; *(u32x4*)(QI + rr * 528 + cc * 16) = rq[i]; *(u32x4*)(KI + rr * 528 + cc * 16) = rk[i]; }
        if (tid < 64) { unsigned char* d = AGB + (tid >> 1) * 80 + (tid & 1) * 16; *(u32x4*)d = rag; *(u32x4*)(d + 32) = rag; }
        if (it + 1 < count) PRE_LOAD(item + 1);
        LBAR();
#pragma unroll
        for (int lt2 = 0; lt2 < 2; ++lt2) { const bf16x8 agf = *(const bf16x8*)(AGB + (lt2 * 16 + r16) * 80 + q4 * 16);
#pragma unroll
            for (int t2 = 0; t2 < 2; ++t2) { f32x4 g4 = __builtin_amdgcn_mfma_f32_16x16x32_bf16(agf, wfr[t2], (f32x4){0.f, 0.f, 0.f, 0.f}, 0, 0, 0);
#pragma unroll
                for (int j = 0; j < 4; ++j) LA[(lt2 * 16 + q4 * 4 + j) * 260 + (wave * 2 + t2) * 16 + r16] = logsig16(g4[j] + bak[t2]); } }
        LBAR();
        { float bl[16]; float blast;
          { float run = 0.f;
#pragma unroll
            for (int l = 0; l < 32; ++l) { run += LA[l * 260 + kcol]; if ((l >> 4) == half) bl[l & 15] = run; }
            blast = run; }
          const float dec = __expf(blast);
          if (half == 0) DECg[(size_t)item * 256 + kcol] = dec;
          unsigned kdp[8];
#pragma unroll
          for (int i = 0; i < 16; i += 2) { float kd2[2];
#pragma unroll
              for (int e = 0; e < 2; ++e) { const int l = half * 16 + i + e; const float bb = bl[i + e];
                  const float eq = __expf(bb) * 0.0625f, ek = __expf(-bb), ed = dec * ek;
                  bf16_t* qp = (bf16_t*)(QI + l * 528) + kcol; bf16_t* kp = (bf16_t*)(KI + l * 528) + kcol;
                  const float qv = bf2f(*qp), kv = bf2f(*kp); *qp = f2bf(qv * eq); *kp = f2bf(kv * ek); kd2[e] = kv * ed; }
              kdp[i >> 1] = cvt_pk_bf16(kd2[0], kd2[1]); }
          u32x4* kg = (u32x4*)(KDg + ((size_t)item * 256 + kcol) * 32 + half * 16); kg[0] = (u32x4){kdp[0], kdp[1], kdp[2], kdp[3]}; kg[1] = (u32x4){kdp[4], kdp[5], kdp[6], kdp[7]}; }
        LBAR();
        if (wave < 4) { const int lt2 = (wave == 1 || wave == 2) ? 1 : 0, mt = (wave >= 2) ? 1 : 0;
            f32x4 aacc = (f32x4){0.f, 0.f, 0.f, 0.f};
            if (wave < 3) {
#pragma unroll
                for (int kk = 0; kk < 8; ++kk) { const bf16x8 af = *(const bf16x8*)(KI + (mt * 16 + r16) * 528 + kk * 64 + q4 * 16); const bf16x8 bfg = *(const bf16x8*)(QI + (lt2 * 16 + r16) * 528 + kk * 64 + q4 * 16);
                    aacc = __builtin_amdgcn_mfma_f32_16x16x32_bf16(af, bfg, aacc, 0, 0, 0); } }
            const int l = lt2 * 16 + r16, m0 = mt * 16 + q4 * 4; float v4[4];
#pragma unroll
            for (int j = 0; j < 4; ++j) v4[j] = (m0 + j <= l) ? aacc[j] : 0.f;
            *(u32x2*)(AMg + ((size_t)item * 32 + l) * 32 + m0) = (u32x2){cvt_pk_bf16(v4[0], v4[1]), cvt_pk_bf16(v4[2], v4[3])}; }
#pragma unroll
        for (int i = 0; i < 2; ++i) { const int ch = tid + i * 512, rr = ch >> 5, cc = ch & 31; *(u32x4*)(QIg + ((size_t)item * 32 + rr) * 256 + cc * 8) = *(const u32x4*)(QI + rr * 528 + cc * 16); }
        LBAR();
    }
    __syncthreads();
#undef PRE_LOAD
}

__device__ __forceinline__ void gla_prompt_unit(const Args& a, unsigned char* lds, int unit, int tid) {
    const int lane = tid & 63, wave = tid >> 6, r16 = lane & 15, q4 = lane >> 4;
    const int bh = unit >> 3, vs = unit & 7, b = bh >> 2, h = bh & 3;
    unsigned char* QI = lds; unsigned char* KDT = lds + 33792; unsigned char* ST = lds + 54272;
    unsigned char* VT = lds + 88064; unsigned char* AM = lds + 93184; float* DEC = (float*)(lds + 98304);
    const bf16_t* Z = (const bf16_t*)(a.ws + WS_Z); bf16_t* OCAT = (bf16_t*)(a.ws + WS_OCAT); float* GSS = (float*)(a.ws + WS_GSSP);
    const bf16_t* QIg = (const bf16_t*)(a.ws + WS_QIG); const bf16_t* KDg = (const bf16_t*)(a.ws + WS_KDG); const bf16_t* AMg = (const bf16_t*)(a.ws + WS_AMG); const float* DECg = (const float*)(a.ws + WS_DECG);
    for (int i = tid; i < 33792 / 16; i += 512) ((u32x4*)ST)[i] = (u32x4){0u, 0u, 0u, 0u};
    f32x4 sacc[2][4];
#pragma unroll
    for (int i = 0; i < 2; ++i)
#pragma unroll
        for (int j = 0; j < 4; ++j) sacc[i][j] = (f32x4){0.f, 0.f, 0.f, 0.f};
    const size_t rowbase = (size_t)b * 2048;
    u32x4 rq[2], rkd[2], rv = (u32x4){0u, 0u, 0u, 0u}, ram = (u32x4){0u, 0u, 0u, 0u}, rdec = (u32x4){0u, 0u, 0u, 0u};
#define GLA_LOAD(n) do { const size_t it_ = (size_t)bh * 64 + (n); _Pragma("unroll") for (int i_ = 0; i_ < 2; ++i_) { const int ch_ = tid + i_ * 512; \
        rq[i_] = *(const u32x4*)(QIg + it_ * 8192 + (size_t)ch_ * 8); rkd[i_] = *(const u32x4*)(KDg + it_ * 8192 + (size_t)ch_ * 8); } \
        if (tid < 128) ram = *(const u32x4*)(AMg + it_ * 1024 + tid * 8); \
        if (tid >= 128 && tid < 192) rdec = *(const u32x4*)(DECg + it_ * 256 + (tid - 128) * 4); \
        if (tid >= 256) rv = *(const u32x4*)(Z + (rowbase + (size_t)(n) * 32 + (tid & 31)) * DINP + ZVG + h * 512 + vs * 64 + ((tid - 256) >> 5) * 8); } while (0)
    GLA_LOAD(0);
    for (int n = 0; n < 64; ++n) {
        const size_t row0 = rowbase + (size_t)n * 32;
#pragma unroll
        for (int i = 0; i < 2; ++i) { const int ch = tid + i * 512; *(u32x4*)(QI + (ch >> 5) * 528 + (ch & 31) * 16) = rq[i]; *(u32x4*)(KDT + (ch >> 2) * 80 + (ch & 3) * 16) = rkd[i]; }
        if (tid < 128) *(u32x4*)(AM + (tid >> 2) * 80 + (tid & 3) * 16) = ram;
        if (tid >= 128 && tid < 192) *(u32x4*)(DEC + (tid - 128) * 4) = rdec;
        if (tid >= 256) { const int l = tid & 31, c8 = (tid - 256) >> 5; bf16_t* vt = (bf16_t*)VT + (c8 * 8) * 40 + l;
            vt[0 * 40] = (bf16_t)(rv.x & 0xffffu); vt[1 * 40] = (bf16_t)(rv.x >> 16); vt[2 * 40] = (bf16_t)(rv.y & 0xffffu); vt[3 * 40] = (bf16_t)(rv.y >> 16);
            vt[4 * 40] = (bf16_t)(rv.z & 0xffffu); vt[5 * 40] = (bf16_t)(rv.z >> 16); vt[6 * 40] = (bf16_t)(rv.w & 0xffffu); vt[7 * 40] = (bf16_t)(rv.w >> 16); }
        if (n + 1 < 64) GLA_LOAD(n + 1);
        LBAR();
        const int vt = wave & 3, lt = wave >> 2;
        f32x4 oacc = (f32x4){0.f, 0.f, 0.f, 0.f};
#pragma unroll
        for (int kk = 0; kk < 8; ++kk) { const bf16x8 af = *(const bf16x8*)(ST + (vt * 16 + r16) * 528 + kk * 64 + q4 * 16); const bf16x8 bfg = *(const bf16x8*)(QI + (lt * 16 + r16) * 528 + kk * 64 + q4 * 16);
            oacc = __builtin_amdgcn_mfma_f32_16x16x32_bf16(af, bfg, oacc, 0, 0, 0); }
        { const bf16x8 af = *(const bf16x8*)(VT + (vt * 16 + r16) * 80 + q4 * 16); const bf16x8 bfg = *(const bf16x8*)(AM + (lt * 16 + r16) * 80 + q4 * 16);
          oacc = __builtin_amdgcn_mfma_f32_16x16x32_bf16(af, bfg, oacc, 0, 0, 0);
          MFMA_SETTLE1(oacc);
          const size_t row = row0 + lt * 16 + r16;
          *(u32x2*)(OCAT + row * OC + 1024 + h * 512 + vs * 64 + vt * 16 + q4 * 4) = (u32x2){cvt_pk_bf16(oacc[0], oacc[1]), cvt_pk_bf16(oacc[2], oacc[3])};
          float ss = (oacc[0] * oacc[0] + oacc[1] * oacc[1]) + (oacc[2] * oacc[2] + oacc[3] * oacc[3]); ss += __shfl_xor(ss, 16); ss += __shfl_xor(ss, 32);
          if (lane < 16) GSS[(row * 4 + h) * 32 + vs * 4 + vt] = ss; }
        LBAR();
#pragma unroll
        for (int k2 = 0; k2 < 2; ++k2) { const int kt = wave * 2 + k2; const f32x4 dec4 = *(const f32x4*)(DEC + kt * 16 + q4 * 4); const bf16x8 af = *(const bf16x8*)(KDT + (kt * 16 + r16) * 80 + q4 * 16);
#pragma unroll
            for (int v2 = 0; v2 < 4; ++v2) { const bf16x8 bfg = *(const bf16x8*)(VT + (v2 * 16 + r16) * 80 + q4 * 16);
                sacc[k2][v2] = __builtin_amdgcn_mfma_f32_16x16x32_bf16(af, bfg, sacc[k2][v2] * dec4, 0, 0, 0); } }
        MFMA_SETTLE8(sacc[0][0], sacc[0][1], sacc[0][2], sacc[0][3], sacc[1][0], sacc[1][1], sacc[1][2], sacc[1][3]);
#pragma unroll
        for (int k2 = 0; k2 < 2; ++k2) { const int kt = wave * 2 + k2;
#pragma unroll
            for (int v2 = 0; v2 < 4; ++v2)
                *(u32x2*)(ST + (v2 * 16 + r16) * 528 + (kt * 16 + q4 * 4) * 2) = (u32x2){cvt_pk_bf16(sacc[k2][v2][0], sacc[k2][v2][1]), cvt_pk_bf16(sacc[k2][v2][2], sacc[k2][v2][3])}; }
        LBAR();
    }
    float* SP = a.out + OUT_SP + (size_t)bh * 256 * 512;
#pragma unroll
    for (int k2 = 0; k2 < 2; ++k2)
#pragma unroll
        for (int v2 = 0; v2 < 4; ++v2)
#pragma unroll
            for (int j = 0; j < 4; ++j) SP[(size_t)((wave * 2 + k2) * 16 + q4 * 4 + j) * 512 + vs * 64 + v2 * 16 + r16] = sacc[k2][v2][j];
    __syncthreads();
#undef GLA_LOAD
}

__device__ __forceinline__ void swa_prompt_unit(const Args& a, unsigned char* lds, int unit, int tid) {
    const int lane = tid & 63, wave = tid >> 6, r16 = lane & 15, q4 = lane >> 4;
    const int kvh = unit & 3, blk = (unit >> 2) & 15, b = unit >> 6;
    unsigned char* KL = lds; unsigned char* VTL = lds + 36864;
    const bf16_t* Z = (const bf16_t*)(a.ws + WS_Z); bf16_t* OCAT = (bf16_t*)(a.ws + WS_OCAT); const f32x2* ROPE = (const f32x2*)(a.ws + WS_ROPE);
#pragma unroll
    for (int it = 0; it < 4; ++it) { const int e = tid + it * 512, j = e >> 3, c = e & 7; const int kpos = (blk - 1) * 128 + j; const bool valid = kpos >= 0;
        const size_t row = (size_t)b * 2048 + (valid ? kpos : 0);
        u32x4 raw = (u32x4){0u, 0u, 0u, 0u}, rawv = (u32x4){0u, 0u, 0u, 0u}; float kf[8];
        if (valid) { raw = *(const u32x4*)(Z + row * DINP + ZKS + kvh * 64 + c * 8); rawv = *(const u32x4*)(Z + row * DINP + ZVS + kvh * 64 + c * 8); }
        kf[0] = bflo(raw.x); kf[1] = bfhi(raw.x); kf[2] = bflo(raw.y); kf[3] = bfhi(raw.y); kf[4] = bflo(raw.z); kf[5] = bfhi(raw.z); kf[6] = bflo(raw.w); kf[7] = bfhi(raw.w);
        if (c < 2 && valid) { const u32x4 pr = *(const u32x4*)(Z + row * DINP + ZKS + kvh * 64 + (c ^ 1) * 8);
            float pf[8]; pf[0] = bflo(pr.x); pf[1] = bfhi(pr.x); pf[2] = bflo(pr.y); pf[3] = bfhi(pr.y); pf[4] = bflo(pr.z); pf[5] = bfhi(pr.z); pf[6] = bflo(pr.w); pf[7] = bfhi(pr.w);
            const f32x2* rp = ROPE + kpos * 8; const float sg = c == 0 ? -1.f : 1.f;
#pragma unroll
            for (int d = 0; d < 8; ++d) { const f32x2 cs = rp[d]; kf[d] = kf[d] * cs.x + sg * pf[d] * cs.y; }
            raw.x = cvt_pk_bf16(kf[0], kf[1]); raw.y = cvt_pk_bf16(kf[2], kf[3]); raw.z = cvt_pk_bf16(kf[4], kf[5]); raw.w = cvt_pk_bf16(kf[6], kf[7]);
            kf[0] = bflo(raw.x); kf[1] = bfhi(raw.x); kf[2] = bflo(raw.y); kf[3] = bfhi(raw.y); kf[4] = bflo(raw.z); kf[5] = bfhi(raw.z); kf[6] = bflo(raw.w); kf[7] = bfhi(raw.w); }
        *(u32x4*)(KL + j * 144 + c * 16) = raw;
        bf16_t* vt = (bf16_t*)VTL + (c * 8) * 264 + j;
        vt[0 * 264] = (bf16_t)(rawv.x & 0xffffu); vt[1 * 264] = (bf16_t)(rawv.x >> 16); vt[2 * 264] = (bf16_t)(rawv.y & 0xffffu); vt[3 * 264] = (bf16_t)(rawv.y >> 16);
        vt[4 * 264] = (bf16_t)(rawv.z & 0xffffu); vt[5 * 264] = (bf16_t)(rawv.z >> 16); vt[6 * 264] = (bf16_t)(rawv.w & 0xffffu); vt[7 * 264] = (bf16_t)(rawv.w >> 16);
        if (blk == 15 && j >= 128) { const size_t o = ((size_t)(b * 128 + (j - 128)) * 4 + kvh) * 64 + c * 8;
            *(f32x4*)(a.out + OUT_KP + o) = (f32x4){kf[0], kf[1], kf[2], kf[3]}; *(f32x4*)(a.out + OUT_KP + o + 4) = (f32x4){kf[4], kf[5], kf[6], kf[7]};
            *(f32x4*)(a.out + OUT_VP + o) = (f32x4){bflo(rawv.x), bfhi(rawv.x), bflo(rawv.y), bfhi(rawv.y)}; *(f32x4*)(a.out + OUT_VP + o + 4) = (f32x4){bflo(rawv.z), bfhi(rawv.z), bflo(rawv.w), bfhi(rawv.w)}; } }
    __syncthreads();
    const int g = wave >> 1; const float sk = a.sink[kvh * 4 + g];
    for (int qt = 0; qt < 4; ++qt) {
        const int q0 = (wave & 1) * 64 + qt * 16, qi = q0 + r16, qpos = blk * 128 + qi; const size_t row = (size_t)b * 2048 + qpos;
        bf16x8 qf[2];
#pragma unroll
        for (int kk = 0; kk < 2; ++kk) { const int c = kk * 4 + q4; const bf16_t* qp = Z + row * DINP + ZQS + (kvh * 4 + g) * 64;
            const u32x4 raw = *(const u32x4*)(qp + c * 8); float f[8];
            f[0] = bflo(raw.x); f[1] = bfhi(raw.x); f[2] = bflo(raw.y); f[3] = bfhi(raw.y); f[4] = bflo(raw.z); f[5] = bfhi(raw.z); f[6] = bflo(raw.w); f[7] = bfhi(raw.w);
            if (kk == 0 && q4 < 2) { const u32x4 pr = *(const u32x4*)(qp + (c ^ 1) * 8);
                float pf[8]; pf[0] = bflo(pr.x); pf[1] = bfhi(pr.x); pf[2] = bflo(pr.y); pf[3] = bfhi(pr.y); pf[4] = bflo(pr.z); pf[5] = bfhi(pr.z); pf[6] = bflo(pr.w); pf[7] = bfhi(pr.w);
                const f32x2* rp = ROPE + qpos * 8; const float sg = c == 0 ? -1.f : 1.f;
#pragma unroll
                for (int d = 0; d < 8; ++d) { const f32x2 cs = rp[d]; f[d] = f[d] * cs.x + sg * pf[d] * cs.y; } }
            u32x4 w; w.x = cvt_pk_bf16(f[0] * 0.125f, f[1] * 0.125f); w.y = cvt_pk_bf16(f[2] * 0.125f, f[3] * 0.125f); w.z = cvt_pk_bf16(f[4] * 0.125f, f[5] * 0.125f); w.w = cvt_pk_bf16(f[6] * 0.125f, f[7] * 0.125f);
            asm volatile("s_nop 4" : "+v"(w));
            qf[kk] = __builtin_bit_cast(bf16x8, w); }
        const int t0 = (wave & 1) * 4 + qt;
        f32x4 sc[16];
#pragma unroll
        for (int t = 0; t < 16; ++t) { sc[t] = (f32x4){0.f, 0.f, 0.f, 0.f};
            if (t >= t0 && t <= t0 + 8) {
#pragma unroll
                for (int kk = 0; kk < 2; ++kk) { const bf16x8 af = *(const bf16x8*)(KL + (t * 16 + r16) * 144 + kk * 64 + q4 * 16); sc[t] = __builtin_amdgcn_mfma_f32_16x16x32_bf16(af, qf[kk], sc[t], 0, 0, 0); } } }
        float mx = -3.0e38f;
#pragma unroll
        for (int t = 0; t < 16; ++t) if (t >= t0 && t <= t0 + 8) {
            if (t > t0 && t < t0 + 8 && (blk > 0 || t >= 8)) { mx = fmaxf(mx, fmaxf(fmaxf(sc[t][0], sc[t][1]), fmaxf(sc[t][2], sc[t][3]))); }
            else {
#pragma unroll
            for (int j = 0; j < 4; ++j) { const int key = t * 16 + q4 * 4 + j; const bool ok = key > qi && key <= qi + 128 && (blk > 0 || key >= 128); if (ok) mx = fmaxf(mx, sc[t][j]); } } }
        mx = fmaxf(mx, __shfl_xor(mx, 16)); mx = fmaxf(mx, __shfl_xor(mx, 32)); mx = fmaxf(mx, sk);
        float sum = 0.f;
#pragma unroll
        for (int t = 0; t < 16; ++t) { if (t >= t0 && t <= t0 + 8) {
            if (t > t0 && t < t0 + 8 && (blk > 0 || t >= 8)) {
#pragma unroll
                for (int j = 0; j < 4; ++j) { const float p = __expf(sc[t][j] - mx); sc[t][j] = p; sum += p; } }
            else {
#pragma unroll
            for (int j = 0; j < 4; ++j) { const int key = t * 16 + q4 * 4 + j; const bool ok = key > qi && key <= qi + 128 && (blk > 0 || key >= 128); const float p = ok ? __expf(sc[t][j] - mx) : 0.f; sc[t][j] = p; sum += p; } } }
            else sc[t] = (f32x4){0.f, 0.f, 0.f, 0.f}; }
        sum += __shfl_xor(sum, 16); sum += __shfl_xor(sum, 32);
        const float inv = 1.f / (sum + __expf(sk - mx));
        f32x4 oacc[4];
#pragma unroll
        for (int dt = 0; dt < 4; ++dt) oacc[dt] = (f32x4){0.f, 0.f, 0.f, 0.f};
#pragma unroll
        for (int i = 0; i < 8; ++i) if (2 * i + 1 >= t0 && 2 * i <= t0 + 8) { u32x4 w; w.x = cvt_pk_bf16(sc[2 * i][0] * inv, sc[2 * i][1] * inv); w.y = cvt_pk_bf16(sc[2 * i][2] * inv, sc[2 * i][3] * inv);
            w.z = cvt_pk_bf16(sc[2 * i + 1][0] * inv, sc[2 * i + 1][1] * inv); w.w = cvt_pk_bf16(sc[2 * i + 1][2] * inv, sc[2 * i + 1][3] * inv);
            asm volatile("s_nop 4" : "+v"(w));
            const bf16x8 pf = __builtin_bit_cast(bf16x8, w);
#pragma unroll
            for (int dt = 0; dt < 4; ++dt) { const unsigned char* vp = VTL + (dt * 16 + r16) * 528 + ((2 * i) * 16 + q4 * 4) * 2;
                const u32x2 lo = *(const u32x2*)vp, hi = *(const u32x2*)(vp + 32); const bf16x8 af = __builtin_bit_cast(bf16x8, (u32x4){lo.x, lo.y, hi.x, hi.y});
                oacc[dt] = __builtin_amdgcn_mfma_f32_16x16x32_bf16(af, pf, oacc[dt], 0, 0, 0); } }
        MFMA_SETTLE4(oacc[0], oacc[1], oacc[2], oacc[3]);
#pragma unroll
        for (int dt = 0; dt < 4; ++dt) *(u32x2*)(OCAT + row * OC + (kvh * 4 + g) * 64 + dt * 16 + q4 * 4) = (u32x2){cvt_pk_bf16(oacc[dt][0], oacc[dt][1]), cvt_pk_bf16(oacc[dt][2], oacc[dt][3])};
    }
    __syncthreads();
}

__device__ __forceinline__ void gla_sample_unit(const Args& a, unsigned char* lds, int unit, int tid) {
    const int lane = tid & 63, wave = tid >> 6;
    const int b = unit >> 2, h = unit & 3;
    float* Q4 = (float*)lds;
    float* KD4 = Q4 + 1024;
    float* KI4 = KD4 + 1024;
    float* DECS = KI4 + 1024;
    float* AS = DECS + 256;
    float* RED = AS + 16;
    float* VS = RED + 16;
    float* ORED = VS + 2048;
    const bf16_t* Z = (const bf16_t*)(a.ws + WS_Z); bf16_t* OCAT = (bf16_t*)(a.ws + WS_OCAT);
    const size_t row0 = (size_t)MP + b * 4;
    if (tid < 256) { const int kcol = tid; float la[4];
#pragma unroll
        for (int t = 0; t < 4; ++t) la[t] = a.b_a[h * 256 + kcol];
#pragma unroll
        for (int r = 0; r < 16; ++r) { const float w = a.w_a2[r * 1024 + h * 256 + kcol];
#pragma unroll
            for (int t = 0; t < 4; ++t) la[t] += bf2f(Z[(row0 + t) * DINP + ZAG + r]) * w; }
        float bb[4]; float c = 0.f;
#pragma unroll
        for (int t = 0; t < 4; ++t) { c += logsig16(la[t]); bb[t] = c; }
        f32x4 qv, kd, ki;
#pragma unroll
        for (int t = 0; t < 4; ++t) { const float q = bf2f(Z[(row0 + t) * DINP + ZQG + h * 256 + kcol]), k = bf2f(Z[(row0 + t) * DINP + ZKG + h * 256 + kcol]);
            qv[t] = q * __expf(bb[t]) * 0.0625f; ki[t] = k * __expf(-bb[t]); kd[t] = k * __expf(c - bb[t]); }
        *(f32x4*)(Q4 + kcol * 4) = qv; *(f32x4*)(KD4 + kcol * 4) = kd; *(f32x4*)(KI4 + kcol * 4) = ki; DECS[kcol] = __expf(c);
    } else { const int j = tid - 256, t = j >> 6, c = j & 63; const u32x4 raw = *(const u32x4*)(Z + (row0 + t) * DINP + ZVG + h * 512 + c * 8);
        float* d = VS + t * 512 + c * 8; *(f32x4*)d = (f32x4){bflo(raw.x), bfhi(raw.x), bflo(raw.y), bfhi(raw.y)}; *(f32x4*)(d + 4) = (f32x4){bflo(raw.z), bfhi(raw.z), bflo(raw.w), bfhi(raw.w)}; }
    __syncthreads();
    { const int pair = tid >> 5, sub = tid & 31, t = pair >> 2, m = pair & 3; float s = 0.f;
#pragma unroll
      for (int i = 0; i < 8; ++i) { const int k = sub + 32 * i; s += Q4[k * 4 + t] * KI4[k * 4 + m]; }
#pragma unroll
      for (int o = 1; o < 32; o <<= 1) s += __shfl_xor(s, o);
      if (sub == 0) AS[t * 4 + m] = (m <= t) ? s : 0.f; }
    const int kq = tid >> 7, vc = (tid & 127) * 4;
    f32x4 vr[4], o[4];
#pragma unroll
    for (int t = 0; t < 4; ++t) { vr[t] = *(const f32x4*)(VS + t * 512 + vc); o[t] = (f32x4){0.f, 0.f, 0.f, 0.f}; }
    const float* S0 = a.s0 + (size_t)unit * 256 * 512; float* SN = a.out + OUT_SS + (size_t)unit * 256 * 512;
    f32x4 sb[2][8];
#pragma unroll
    for (int i = 0; i < 8; ++i) sb[0][i] = *(const f32x4*)(S0 + (size_t)(i * 4 + kq) * 512 + vc);
#pragma unroll
    for (int g = 0; g < 8; ++g) {
        if (g + 1 < 8) {
#pragma unroll
            for (int i = 0; i < 8; ++i) sb[(g + 1) & 1][i] = *(const f32x4*)(S0 + (size_t)(((g + 1) * 8 + i) * 4 + kq) * 512 + vc); }
#pragma unroll
        for (int i = 0; i < 8; ++i) { const int k = (g * 8 + i) * 4 + kq; const f32x4 s = sb[g & 1][i];
            const f32x4 qv = *(const f32x4*)(Q4 + k * 4), kd = *(const f32x4*)(KD4 + k * 4); const float dec = DECS[k];
            f32x4 sn = s * dec;
#pragma unroll
            for (int t = 0; t < 4; ++t) { sn += vr[t] * kd[t]; o[t] += s * qv[t]; }
            *(f32x4*)(SN + (size_t)k * 512 + vc) = sn; } }
#pragma unroll
    for (int t = 0; t < 4; ++t) *(f32x4*)(ORED + (kq * 4 + t) * 512 + vc) = o[t];
    __syncthreads();
    { const int t = tid >> 7, v4 = (tid & 127) * 4; f32x4 ov = (f32x4){0.f, 0.f, 0.f, 0.f};
#pragma unroll
      for (int q = 0; q < 4; ++q) ov += *(const f32x4*)(ORED + (q * 4 + t) * 512 + v4);
#pragma unroll
      for (int m = 0; m < 4; ++m) ov += *(const f32x4*)(VS + m * 512 + v4) * AS[t * 4 + m];
      float ss = (ov[0] * ov[0] + ov[1] * ov[1]) + (ov[2] * ov[2] + ov[3] * ov[3]); ss = wave_sum(ss);
      if (lane == 0) RED[wave] = ss;
      __syncthreads();
      const float tot = RED[2 * t] + RED[2 * t + 1]; const float rs = rsqrtf(tot * (1.0f / 512.0f) + EPS);
      const size_t row = row0 + t; const u32x2 rgw = *(const u32x2*)(Z + row * DINP + ZRG + h * 512 + v4); const f32x4 gn = *(const f32x4*)(a.gla_norm + v4);
      float r[4] = {bflo(rgw.x), bfhi(rgw.x), bflo(rgw.y), bfhi(rgw.y)}; float w[4];
#pragma unroll
      for (int e = 0; e < 4; ++e) w[e] = ov[e] * rs * gn[e] * (r[e] * sigmoidf_(r[e]));
      *(u32x2*)(OCAT + row * OC + 1024 + h * 512 + v4) = (u32x2){cvt_pk_bf16(w[0], w[1]), cvt_pk_bf16(w[2], w[3])}; }
    __syncthreads();
}

__device__ __forceinline__ void swa_sample_unit(const Args& a, unsigned char* lds, int unit, int tid) {
    const int lane = tid & 63, wave = tid >> 6;
    const int b = unit >> 2, kvh = unit & 3;
    float* KS = (float*)lds;
    float* VS = KS + 132 * 65;
    float* QS = VS + 132 * 64;
    float* PS = QS + 1024;
    const bf16_t* Z = (const bf16_t*)(a.ws + WS_Z); bf16_t* OCAT = (bf16_t*)(a.ws + WS_OCAT); const f32x2* ROPE = (const f32x2*)(a.ws + WS_ROPE);
    const size_t row0 = (size_t)MP + b * 4;
    for (int e = tid; e < 132 * 16; e += 512) { const int j = e >> 4, c = e & 15; f32x4 kv, vv;
        if (j < 128) { const size_t o = ((size_t)(b * 128 + j) * 4 + kvh) * 64 + c * 4; kv = *(const f32x4*)(a.ck + o); vv = *(const f32x4*)(a.cv + o); }
        else { const int i = j - 128; const bf16_t* kp = Z + (row0 + i) * DINP + ZKS + kvh * 64; const u32x2 kw = *(const u32x2*)(kp + c * 4); const u32x2 vw = *(const u32x2*)(Z + (row0 + i) * DINP + ZVS + kvh * 64 + c * 4);
            kv = (f32x4){bflo(kw.x), bfhi(kw.x), bflo(kw.y), bfhi(kw.y)}; vv = (f32x4){bflo(vw.x), bfhi(vw.x), bflo(vw.y), bfhi(vw.y)};
            if (c < 4) { const u32x2 pw = *(const u32x2*)(kp + (c ^ 2) * 4); const f32x4 pv = (f32x4){bflo(pw.x), bfhi(pw.x), bflo(pw.y), bfhi(pw.y)}; const float sg = c < 2 ? -1.f : 1.f;
                const f32x2* rp = ROPE + (2048 + i) * 8 + (c & 1) * 4;
#pragma unroll
                for (int d = 0; d < 4; ++d) { const f32x2 cs = rp[d]; kv[d] = kv[d] * cs.x + sg * pv[d] * cs.y; }
            } }
        float* kd = KS + j * 65 + c * 4; kd[0] = kv[0]; kd[1] = kv[1]; kd[2] = kv[2]; kd[3] = kv[3];
        *(f32x4*)(VS + j * 64 + c * 4) = vv;
        if (j >= 4) { const size_t o = ((size_t)(b * 128 + (j - 4)) * 4 + kvh) * 64 + c * 4; *(f32x4*)(a.out + OUT_KS + o) = kv; *(f32x4*)(a.out + OUT_VS + o) = vv; } }
    if (tid < 256) { const int pr = tid >> 4, c = tid & 15, g = pr >> 2, i = pr & 3; const bf16_t* qp = Z + (row0 + i) * DINP + ZQS + (kvh * 4 + g) * 64; const u32x2 qw = *(const u32x2*)(qp + c * 4);
        f32x4 qv = (f32x4){bflo(qw.x), bfhi(qw.x), bflo(qw.y), bfhi(qw.y)};
        if (c < 4) { const u32x2 pw = *(const u32x2*)(qp + (c ^ 2) * 4); const f32x4 pv = (f32x4){bflo(pw.x), bfhi(pw.x), bflo(pw.y), bfhi(pw.y)}; const float sg = c < 2 ? -1.f : 1.f;
            const f32x2* rp = ROPE + (2048 + i) * 8 + (c & 1) * 4;
#pragma unroll
            for (int d = 0; d < 4; ++d) { const f32x2 cs = rp[d]; qv[d] = qv[d] * cs.x + sg * pv[d] * cs.y; } }
        *(f32x4*)(QS + pr * 64 + c * 4) = qv * 0.125f; }
    __syncthreads();
    for (int pp = 0; pp < 2; ++pp) { const int pr = wave + pp * 8, g = pr >> 2, i = pr & 3; const float sk = a.sink[kvh * 4 + g];
        float s[3]; float mx = -3.0e38f;
#pragma unroll
        for (int jj = 0; jj < 3; ++jj) { const int j = lane + 64 * jj; float acc = 0.f;
            if (j < 132) {
#pragma unroll 16
                for (int d = 0; d < 64; ++d) acc += QS[pr * 64 + d] * KS[j * 65 + d]; }
            const bool ok = j < 132 && j > i && j <= i + 128; s[jj] = ok ? acc : -3.0e38f; mx = fmaxf(mx, s[jj]); }
        mx = fmaxf(wave_max(mx), sk); float sum = 0.f;
#pragma unroll
        for (int jj = 0; jj < 3; ++jj) { const int j = lane + 64 * jj; const bool ok = j < 132 && j > i && j <= i + 128; s[jj] = ok ? __expf(s[jj] - mx) : 0.f; sum += s[jj]; }
        sum = wave_sum(sum); const float inv = 1.f / (sum + __expf(sk - mx));
#pragma unroll
        for (int jj = 0; jj < 3; ++jj) { const int j = lane + 64 * jj; if (j < 132) PS[wave * 136 + j] = s[jj] * inv; }
        __syncthreads();
        float o = 0.f;
#pragma unroll 4
        for (int j = 0; j < 132; ++j) o += PS[wave * 136 + j] * VS[j * 64 + lane];
        OCAT[(row0 + i) * OC + (kvh * 4 + g) * 64 + lane] = f2bf(o);
        __syncthreads(); }
}


template <class Epi>
__device__ __forceinline__ void small_gemm_tile(unsigned char* lds, const bf16_t* A, int lda, const bf16_t* Bt, int ldb, int K, int kbreak, int rowbase, int tm, int tn, const Epi& E, int tid) {
    const int lane = tid & 63, wave = tid >> 6, r16 = lane & 15, q4 = lane >> 4, wm = wave >> 1, wn = wave & 1;
    unsigned char* AS = lds; unsigned char* BS = lds + 33792; float* RED = (float*)(lds + 67584);
    const bf16_t* Ag = A + (size_t)(rowbase + tm * 64) * lda; const bf16_t* Bg = Bt + (size_t)(tn * 64) * ldb;
    u32x4 ra[4], rb[4];
#define SG_LOAD(k0) do { _Pragma("unroll") for (int i_ = 0; i_ < 4; ++i_) { const int id_ = tid + i_ * 512, rr_ = id_ >> 5, cc_ = id_ & 31; \
        ra[i_] = *(const u32x4*)(Ag + (size_t)rr_ * lda + (k0) + cc_ * 8); rb[i_] = *(const u32x4*)(Bg + (size_t)rr_ * ldb + (k0) + cc_ * 8); } } while (0)
    f32x4 cur[2], first[2];
#pragma unroll
    for (int n_ = 0; n_ < 2; ++n_) { cur[n_] = (f32x4){0.f, 0.f, 0.f, 0.f}; first[n_] = (f32x4){0.f, 0.f, 0.f, 0.f}; }
    SG_LOAD(0);
    for (int k0 = 0; k0 < K; k0 += 256) {
#pragma unroll
        for (int i = 0; i < 4; ++i) { const int id = tid + i * 512, rr = id >> 5, cc = id & 31; *(u32x4*)(AS + rr * 528 + cc * 16) = ra[i]; *(u32x4*)(BS + rr * 528 + cc * 16) = rb[i]; }
        LBAR();
        if (k0 + 256 < K) SG_LOAD(k0 + 256);
        if (k0 == kbreak) {
#pragma unroll
            for (int n_ = 0; n_ < 2; ++n_) { first[n_] = cur[n_]; cur[n_] = (f32x4){0.f, 0.f, 0.f, 0.f}; } }
#pragma unroll
        for (int kk = 0; kk < 8; ++kk) { const bf16x8 af = *(const bf16x8*)(AS + (wm * 16 + r16) * 528 + kk * 64 + q4 * 16);
#pragma unroll
            for (int nt = 0; nt < 2; ++nt) { const bf16x8 bfg = *(const bf16x8*)(BS + (wn * 32 + nt * 16 + r16) * 528 + kk * 64 + q4 * 16); cur[nt] = __builtin_amdgcn_mfma_f32_16x16x32_bf16(bfg, af, cur[nt], 0, 0, 0); } }
        LBAR();
    }
    MFMA_SETTLE4(cur[0], cur[1], first[0], first[1]);
    const int row = rowbase + tm * 64 + wm * 16 + r16; float ssq = 0.f;
#pragma unroll
    for (int nt = 0; nt < 2; ++nt) ssq += E(cur[nt], first[nt], row, tn * 64 + wn * 32 + nt * 16 + q4 * 4);
    if (Epi::SUMSQ) { ssq += __shfl_xor(ssq, 16); ssq += __shfl_xor(ssq, 32);
        if (lane < 16) RED[wn * 64 + wm * 16 + r16] = ssq;
        __syncthreads();
        if (tid < 64) E.ss[(size_t)(rowbase + tm * 64 + tid) * 32 + tn] = RED[tid] + RED[64 + tid];
    }
    __syncthreads();
#undef SG_LOAD
}
struct SmAg {
    static constexpr bool SUMSQ = false;
    bf16_t* Z; const float* ss1; float* ss;
    __device__ __forceinline__ float operator()(const f32x4& a0, const f32x4&, int row, int col) const {
        if (col < DIN) { const float rs = 1.0f; *(u32x2*)(Z + (size_t)row * DINP + col) = (u32x2){cvt_pk_bf16(a0[0] * rs, a0[1] * rs), cvt_pk_bf16(a0[2] * rs, a0[3] * rs)}; }
        return 0.f; }
};
struct SmMergeA {
    static constexpr bool SUMSQ = false;
    const bf16_t* Z; float* T; float* ss;
    __device__ __forceinline__ float operator()(const f32x4& a0, const f32x4&, int row, int col) const {
        const u32x2 gs = *(const u32x2*)(Z + (size_t)row * DINP + ZGS + col); f32x4 o;
        o[0] = a0[0] * sigmoidf_(bflo(gs.x)); o[1] = a0[1] * sigmoidf_(bfhi(gs.x)); o[2] = a0[2] * sigmoidf_(bflo(gs.y)); o[3] = a0[3] * sigmoidf_(bfhi(gs.y));
        *(f32x4*)(T + (size_t)row * DM + col) = o; return 0.f; }
};
struct SmMergeB {
    static constexpr bool SUMSQ = false;
    const bf16_t* Z; const float* T; bf16_t* Y; float* ss;
    __device__ __forceinline__ float operator()(const f32x4& a0, const f32x4&, int row, int col) const {
        const u32x2 gg = *(const u32x2*)(Z + (size_t)row * DINP + ZGG + col); const f32x4 t = *(const f32x4*)(T + (size_t)row * DM + col); f32x4 o;
        o[0] = t[0] + a0[0] * sigmoidf_(bflo(gg.x)); o[1] = t[1] + a0[1] * sigmoidf_(bfhi(gg.x)); o[2] = t[2] + a0[2] * sigmoidf_(bflo(gg.y)); o[3] = t[3] + a0[3] * sigmoidf_(bfhi(gg.y));
        *(u32x2*)(Y + (size_t)row * DM + col) = (u32x2){cvt_pk_bf16(o[0], o[1]), cvt_pk_bf16(o[2], o[3])}; return 0.f; }
};
template <int MODE> struct SmResidB {
    static constexpr bool SUMSQ = true;
    const float* basef; const bf16_t* baseb; bf16_t* ob; float* ss;
    __device__ __forceinline__ float operator()(const f32x4& a0, const f32x4&, int row, int col) const {
        f32x4 o;
        if (MODE == 0) o = *(const f32x4*)(basef + (size_t)row * DM + col) + a0;
        else { const u32x2 w = *(const u32x2*)(baseb + (size_t)row * DM + col); o = (f32x4){bflo(w.x) + a0[0], bfhi(w.x) + a0[1], bflo(w.y) + a0[2], bfhi(w.y) + a0[3]}; }
        *(u32x2*)(ob + (size_t)row * DM + col) = (u32x2){cvt_pk_bf16(o[0], o[1]), cvt_pk_bf16(o[2], o[3])};
        return (o[0] * o[0] + o[1] * o[1]) + (o[2] * o[2] + o[3] * o[3]); }
};
template <bool WB> struct SmResid {
    static constexpr bool SUMSQ = true;
    const float* base; float* out; bf16_t* ob; float* ss;
    __device__ __forceinline__ float operator()(const f32x4& a0, const f32x4&, int row, int col) const {
        const f32x4 o = *(const f32x4*)(base + (size_t)row * DM + col) + a0; *(f32x4*)(out + (size_t)row * DM + col) = o;
        if (WB) *(u32x2*)(ob + (size_t)row * DM + col) = (u32x2){cvt_pk_bf16(o[0], o[1]), cvt_pk_bf16(o[2], o[3])};
        return (o[0] * o[0] + o[1] * o[1]) + (o[2] * o[2] + o[3] * o[3]); }
};

#define XB_TMO      128
#define XB_XCNT(j)  (256  + 64 * (j))
#define XB_XSUB(j)  (1280 + 64 * (j))
#define XB_XGEN(j)  (2304 + 64 * (j))
#define XB_TOP      3328
#define XB_TOPGEN   3392
#define XCD_BAR_WORDS 3456
#define XB_SPIN_CAP (1u << 18)

__device__ __forceinline__ unsigned xb_ld(unsigned* p)              { return __hip_atomic_load(p, __ATOMIC_RELAXED, __HIP_MEMORY_SCOPE_AGENT); }
__device__ __forceinline__ unsigned xb_add(unsigned* p, unsigned v) { return __hip_atomic_fetch_add(p, v, __ATOMIC_RELAXED, __HIP_MEMORY_SCOPE_AGENT); }
__device__ __forceinline__ unsigned xb_xcc_id() { return (unsigned)__builtin_amdgcn_s_getreg((3 << 11) | 20) & 0xFu; }
#define XB_SPIN(cond, bar) do { unsigned _sp = 0; while (cond) { __builtin_amdgcn_s_sleep(1); \
    if ((++_sp & 255u) == 0u) { if (xb_ld(&(bar)[XB_TMO])) break; if (_sp > XB_SPIN_CAP) { atomicAdd(&(bar)[XB_TMO], 1u); break; } } } } while (0)

struct XcdBarrier {
    unsigned* bar; unsigned x;
    volatile LAS unsigned* st;
};

__device__ __forceinline__ XcdBarrier xcd_barrier_post(unsigned* bar, volatile LAS unsigned* st) {
    XcdBarrier b; b.bar = bar; b.x = xb_xcc_id(); b.st = st;
    if (threadIdx.x == 0) (void)xb_add(&bar[XB_XCNT(b.x)], 1u);
    return b;
}
__device__ __forceinline__ void xcd_barrier_complete(unsigned* bar, unsigned x, unsigned& nloc, unsigned& nx) {
    const unsigned G = gridDim.x * gridDim.y * gridDim.z;
    unsigned sum, cnt, mine, sp = 0u;
    for (;;) {
        sum = 0u; cnt = 0u; mine = 0u;
#pragma unroll
        for (unsigned j = 0; j < 16; ++j) { const unsigned c = xb_ld(&bar[XB_XCNT(j)]); sum += c; cnt += (c > 0u) ? 1u : 0u; mine = (j == x) ? c : mine; }
        if (sum == G) break;
        __builtin_amdgcn_s_sleep(1);
        if ((++sp & 255u) == 0u) { if (xb_ld(&bar[XB_TMO])) break; if (sp > XB_SPIN_CAP) { atomicAdd(&bar[XB_TMO], 1u); break; } }
    }
    nloc = mine > 0u ? mine : 1u; nx = cnt > 0u ? cnt : 1u;
}

__device__ __forceinline__ void xcd_barrier(const XcdBarrier& b) {
    asm volatile("s_waitcnt vmcnt(0)" ::: "memory");
    __syncthreads();
    if (threadIdx.x == 0) {
        unsigned* bar = b.bar;
        __builtin_amdgcn_s_waitcnt(0);
        unsigned nloc = b.st[0], nx = b.st[1];
        if (nloc == 0u) { xcd_barrier_complete(bar, b.x, nloc, nx); b.st[0] = nloc; b.st[1] = nx; }
        const unsigned old = xb_add(&bar[XB_XSUB(b.x)], 1u);
        const unsigned gen = old / nloc;
        if (old + 1u == (gen + 1u) * nloc) {
            __builtin_amdgcn_fence(__ATOMIC_RELEASE, "agent");
            asm volatile("s_waitcnt vmcnt(0)" ::: "memory");
            const unsigned og = xb_add(&bar[XB_TOP], 1u);
            const unsigned tg = og / nx;
            if (og + 1u == (tg + 1u) * nx) xb_add(&bar[XB_TOPGEN], 1u);
            else XB_SPIN(xb_ld(&bar[XB_TOPGEN]) == tg, bar);
            __builtin_amdgcn_fence(__ATOMIC_ACQUIRE, "agent");
            xb_add(&bar[XB_XGEN(b.x)], 1u);
            asm volatile("s_waitcnt vmcnt(0)" ::: "memory");
        } else {
            XB_SPIN(xb_ld(&bar[XB_XGEN(b.x)]) == gen, bar);
            __builtin_amdgcn_fence(__ATOMIC_ACQUIRE, "agent");
            asm volatile("s_waitcnt vmcnt(0)" ::: "memory");
        }
    }
    __syncthreads();
}


__global__ void __launch_bounds__(512, 2) hybrid_fwd(Args a) {
    extern __shared__ __attribute__((aligned(16))) unsigned char lds[];
    cg::grid_group grid = cg::this_grid();
    const int tid = threadIdx.x, lane = tid & 63, wave = tid >> 6, G = gridDim.x, bx = blockIdx.x;
    const int vcu = (G % 8 == 0) ? (bx % 8) * (G / 8) + bx / 8 : bx;
    const int gw = bx * 8 + wave, NGW = G * 8;
    unsigned char* ws = a.ws;
    bf16_t* WIN = (bf16_t*)(ws + WS_WIN); bf16_t* PCAT = (bf16_t*)(ws + WS_PCAT); bf16_t* WO = (bf16_t*)(ws + WS_WO); bf16_t* WUP = (bf16_t*)(ws + WS_WUP); bf16_t* WDN = (bf16_t*)(ws + WS_WDN);
    bf16_t* XB = (bf16_t*)(ws + WS_XB); bf16_t* Z = (bf16_t*)(ws + WS_Z); bf16_t* HID = (bf16_t*)(ws + WS_Z); bf16_t* OCAT = (bf16_t*)(ws + WS_OCAT); bf16_t* Y = (bf16_t*)(ws + WS_Y); bf16_t* X1B = (bf16_t*)(ws + WS_X1B);
    float* SS1 = (float*)(ws + WS_SS1); float* SS2 = (float*)(ws + WS_SS2P); float* SSF = (float*)(ws + WS_SSFP); float* GSS = (float*)(ws + WS_GSSP);
    LAS unsigned char* ldsl = (LAS unsigned char*)lds;
    const int lo = a.ph_lo, hi = a.ph_hi;
    volatile LAS unsigned* MISC = (volatile LAS unsigned*)(ldsl + LDS_BYTES - 64);
    if (tid < 2) MISC[tid] = 0u;
    __syncthreads();
    XcdBarrier xbar = xcd_barrier_post((unsigned*)(ws + WS_BAR), MISC);
#define IN(k) (lo <= (k) && (k) < hi)
#define SEAM(k) do { if (IN(k) && IN((k) + 1)) { if ((k) == 0) grid.sync(); else xcd_barrier(xbar); } } while (0)

    if (IN(0)) { phase0(a, lds, tid); } SEAM(0);
    if (IN(1)) { for (int t = bx; t < 264; t += G) { SmAg E{Z, SS1, nullptr}; small_gemm_tile<SmAg>(lds, XB, DM, WIN, DM, DM, -1, 0, t, 184, E, tid); }
        pg8::Gemm g{XB, WIN, M, ZAG, DM, DM, DM}; pg8::StaticOrder S; S.init(M, ZAG, G, bx);
        pg8::EpiScaleBf16<0> E{Z, DINP, SS1}; pg8::gemm_phase<pg8::EpiScaleBf16<0>, pg8::StaticOrder>(ldsl, g, S, E); } SEAM(1);
    if (IN(2)) {
        { const int per = (2048 + G - 1) / G; const int f = vcu * per; const int cnt = f >= 2048 ? 0 : (2048 - f < per ? 2048 - f : per); gla_pre_items(a, lds, f, cnt, tid); }
        for (int u = bx; u < 512; u += G) swa_prompt_unit(a, lds, u, tid);
        for (int u = bx; u < 512; u += G) gla_sample_unit(a, lds, u, tid);
        for (int u = bx; u < 512; u += G) swa_sample_unit(a, lds, u, tid);
        xcd_barrier(xbar);
        for (int u = vcu; u < 256; u += G) gla_prompt_unit(a, lds, u, tid);
    } SEAM(2);
    if (IN(3)) {
        for (int t = bx; t < 256; t += G) { SmMergeA E{Z, a.out, nullptr}; small_gemm_tile<SmMergeA>(lds, OCAT, OC, PCAT, OC, 1024, -1, MP, t >> 5, t & 31, E, tid); }
        for (int t = bx; t < 256; t += G) { SmMergeB E{Z, a.out, Y, nullptr}; small_gemm_tile<SmMergeB>(lds, OCAT + 1024, OC, PCAT + 1024, OC, 2048, -1, MP, t >> 5, t & 31, E, tid); }
        for (int it0 = gw; it0 < MP * 4; it0 += 4 * NGW) {
            u32x4 ow[4], rw[4]; float gp[4];
#pragma unroll
            for (int u = 0; u < 4; ++u) { const int it = it0 + u * NGW; const int row = it >> 2, h = it & 3;
                ow[u] = *(const u32x4*)(OCAT + (size_t)row * OC + 1024 + h * 512 + lane * 8); rw[u] = *(const u32x4*)(Z + (size_t)row * DINP + ZRG + h * 512 + lane * 8);
                gp[u] = lane < 32 ? GSS[(size_t)it * 32 + lane] : 0.f; }
            const f32x4 g0 = *(const f32x4*)(a.gla_norm + lane * 8), g1 = *(const f32x4*)(a.gla_norm + lane * 8 + 4);
            const float gn[8] = {g0[0], g0[1], g0[2], g0[3], g1[0], g1[1], g1[2], g1[3]};
#pragma unroll
            for (int u = 0; u < 4; ++u) { const int it = it0 + u * NGW; const int row = it >> 2, h = it & 3; const float rs = rsqrtf(wave_sum(gp[u]) * (1.0f / 512.0f) + EPS);
                float o[8] = {bflo(ow[u].x), bfhi(ow[u].x), bflo(ow[u].y), bfhi(ow[u].y), bflo(ow[u].z), bfhi(ow[u].z), bflo(ow[u].w), bfhi(ow[u].w)};
                float r[8] = {bflo(rw[u].x), bfhi(rw[u].x), bflo(rw[u].y), bfhi(rw[u].y), bflo(rw[u].z), bfhi(rw[u].z), bflo(rw[u].w), bfhi(rw[u].w)};
#pragma unroll
                for (int e = 0; e < 8; ++e) o[e] = o[e] * rs * gn[e] * (r[e] * sigmoidf_(r[e]));
                *(u32x4*)(OCAT + (size_t)row * OC + 1024 + h * 512 + lane * 8) = (u32x4){cvt_pk_bf16(o[0], o[1]), cvt_pk_bf16(o[2], o[3]), cvt_pk_bf16(o[4], o[5]), cvt_pk_bf16(o[6], o[7])}; } }
    } SEAM(3);
    if (IN(4)) {
        { pg8::Gemm g{OCAT, PCAT, MP, DM, 1024, OC, OC}; pg8::StaticOrder S; S.init(MP, DM, G, bx);
          pg8::EpiMergeA E{(bf16_t*)a.out, Z + ZGS, DINP}; pg8::gemm_phase<pg8::EpiMergeA, pg8::StaticOrder>(ldsl, g, S, E); }
        { pg8::Gemm g{OCAT + 1024, PCAT + 1024, MP, DM, 2048, OC, OC}; pg8::StaticOrder S; S.init(MP, DM, G, bx);
          pg8::EpiMergeB E{(const bf16_t*)a.out, Z + ZGG, DINP, Y}; pg8::gemm_phase<pg8::EpiMergeB, pg8::StaticOrder>(ldsl, g, S, E); }
    } SEAM(4);
    if (IN(5)) {
        for (int t = bx; t < 256; t += G) { SmResidB<0> E{a.xs - (size_t)MP * DM, nullptr, X1B, SS2}; small_gemm_tile<SmResidB<0>>(lds, Y, DM, WO, DM, DM, -1, MP, t >> 5, t & 31, E, tid); }
        { pg8::Gemm g{Y, WO, MP, DM, DM, DM, DM}; pg8::StaticOrder S; S.init(MP, DM, G, bx);
          pg8::EpiResidB<0> E{a.xp, a.xs, nullptr, X1B, SS2}; pg8::gemm_phase<pg8::EpiResidB<0>, pg8::StaticOrder>(ldsl, g, S, E); }
    } SEAM(5);
    if (IN(6)) {
        for (int m = gw; m < M; m += NGW) { const float t_ = wave_sum(lane < 32 ? SS2[(size_t)m * 32 + lane] : 0.f); if (lane == 0) SS1[m] = rsqrtf(t_ * (1.0f / DM) + EPS); }
        xcd_barrier(xbar);
        pg8::Gemm g{X1B, WUP, M, DFF, DM, DM, DM}; pg8::StaticOrder S; S.init(M, DFF, G, bx);
        pg8::EpiScaleBf16<1> E{HID, DFF, SS1}; pg8::gemm_phase<pg8::EpiScaleBf16<1>, pg8::StaticOrder>(ldsl, g, S, E); } SEAM(6);
    if (IN(7)) {
        for (int t = bx; t < 256; t += G) { SmResidB<1> E{nullptr, X1B, Y, SSF}; small_gemm_tile<SmResidB<1>>(lds, HID, DFF, WDN, DFF, DFF, -1, MP, t >> 5, t & 31, E, tid); }
        { pg8::Gemm g{HID, WDN, MP, DM, DFF, DFF, DFF}; pg8::StaticOrder S; S.init(MP, DM, G, bx);
          pg8::EpiResidB<1> E{nullptr, nullptr, X1B, Y, SSF}; pg8::gemm_phase<pg8::EpiResidB<1>, pg8::StaticOrder>(ldsl, g, S, E); }
    } SEAM(7);
    if (IN(8)) {
        for (int m = gw; m < M; m += NGW) { const float sf_ = wave_sum(lane < 32 ? SSF[(size_t)m * 32 + lane] : 0.f); const float rs = rsqrtf(sf_ * (1.0f / DM) + EPS);
            const u32x4* xb = (const u32x4*)(Y + (size_t)m * DM); f32x4* yr = (f32x4*)(a.out + (size_t)m * DM); u32x4 xw[4];
#pragma unroll
            for (int j = 0; j < 4; ++j) xw[j] = xb[lane + 64 * j];
#pragma unroll
            for (int j = 0; j < 4; ++j) { float f[8]; pg8::unpack8(xw[j], f); const int c = (lane + 64 * j) * 8; const f32x4 w0 = *(const f32x4*)(a.fnorm + c), w1 = *(const f32x4*)(a.fnorm + c + 4);
                yr[(lane + 64 * j) * 2] = (f32x4){f[0] * rs * w0[0], f[1] * rs * w0[1], f[2] * rs * w0[2], f[3] * rs * w0[3]}; yr[(lane + 64 * j) * 2 + 1] = (f32x4){f[4] * rs * w1[0], f[5] * rs * w1[1], f[6] * rs * w1[2], f[7] * rs * w1[3]}; } }
    }
#undef IN
#undef SEAM
}

#ifndef N_LAUNCHES
#define N_LAUNCHES 1
#endif
extern "C" void kernel_launch(void* const* d_in, const int* in_sizes, int n_in, void* d_out, int out_size, void* d_ws, size_t ws_size, hipStream_t stream) {
    static int grid = 0;
    if (grid == 0) {
        if (n_in != 18 || (size_t)out_size != OUT_END || ws_size < WS_END) { fprintf(stderr, "kernel_launch: unexpected shapes (n_in %d, out %d, ws %zu)\n", n_in, out_size, ws_size); grid = -1; return; }
        int dev = 0, cus = 0, per_cu = 0;
        hipGetDevice(&dev); hipDeviceGetAttribute(&cus, hipDeviceAttributeMultiprocessorCount, dev);
        hipFuncSetAttribute((const void*)hybrid_fwd, hipFuncAttributeMaxDynamicSharedMemorySize, LDS_BYTES);
        hipOccupancyMaxActiveBlocksPerMultiprocessor(&per_cu, (const void*)hybrid_fwd, 512, LDS_BYTES);
        if (per_cu < 1) { fprintf(stderr, "kernel_launch: occupancy query says %d blocks per CU\n", per_cu); grid = -1; return; }
        grid = cus;
    }
    if (grid < 0) return;
    Args a{};
    a.xp = (const float*)d_in[0]; a.xs = (const float*)d_in[1]; a.ck = (const float*)d_in[2]; a.cv = (const float*)d_in[3]; a.s0 = (const float*)d_in[4];
    a.norm1 = (const float*)d_in[5]; a.w_in = (const float*)d_in[6]; a.w_a2 = (const float*)d_in[7]; a.b_a = (const float*)d_in[8]; a.sink = (const float*)d_in[9];
    a.gla_norm = (const float*)d_in[10]; a.p_swa = (const float*)d_in[11]; a.p_gla = (const float*)d_in[12]; a.w_o = (const float*)d_in[13]; a.norm2 = (const float*)d_in[14];
    a.w_up = (const float*)d_in[15]; a.w_down = (const float*)d_in[16]; a.fnorm = (const float*)d_in[17];
    a.out = (float*)d_out; a.ws = (unsigned char*)d_ws;
    if (hipMemsetAsync((char*)d_ws + WS_BAR, 0, BAR_BYTES, stream) != hipSuccess) { fprintf(stderr, "kernel_launch: hipMemsetAsync failed\n"); return; }
    for (int li = 0; li < N_LAUNCHES; ++li) {
        a.ph_lo = (N_LAUNCHES == 1) ? 0 : li; a.ph_hi = (N_LAUNCHES == 1) ? NPHASE : li + 1;
        void* args[] = {&a};
        hipError_t e = hipLaunchCooperativeKernel((const void*)hybrid_fwd, dim3(grid), dim3(512), args, LDS_BYTES, stream);
        if (e != hipSuccess) { fprintf(stderr, "kernel_launch: cooperative launch %d failed: %s (grid %d)\n", li, hipGetErrorString(e), grid); break; }
    }
}
```

```cpp
#include <hip/hip_runtime.h>
#include <hip/hip_cooperative_groups.h>
#include <cstdio>
#include <cstdint>
namespace cg = cooperative_groups;

#define LAS __attribute__((address_space(3)))
typedef unsigned short bf16_t;
typedef short bf16x8 __attribute__((ext_vector_type(8)));
typedef float f32x4 __attribute__((ext_vector_type(4)));
typedef float f32x2 __attribute__((ext_vector_type(2)));
typedef unsigned u32x4 __attribute__((ext_vector_type(4)));
typedef unsigned u32x2 __attribute__((ext_vector_type(2)));

constexpr int DM = 2048, MP = 16384, MS = 512, M = MP + MS, DIN = 11792, DINP = 12032, DFF = 8192, OC = 3072;
constexpr int ZQS = 0, ZKS = 1024, ZVS = 1280, ZQG = 1536, ZKG = 2560, ZVG = 3584, ZRG = 5632, ZGS = 7680, ZGG = 9728, ZAG = 11776;
constexpr float EPS = 1e-6f;
constexpr size_t MiB = 1u << 20;
constexpr size_t WS_SS1 = 0, WS_BAR = 131072, BAR_BYTES = 16384, WS_ROPE = 655360;
constexpr size_t WS_WIN = 1 * MiB, WS_PCAT = 48 * MiB, WS_WO = 60 * MiB, WS_WUP = 68 * MiB, WS_WDN = 100 * MiB, WS_XB = 132 * MiB,
                 WS_Z = 198 * MiB, WS_OCAT = 586 * MiB, WS_Y = 685 * MiB, WS_X1B = 751 * MiB, WS_SS2P = 817 * MiB, WS_SSFP = 820 * MiB, WS_GSSP = 823 * MiB, WS_END = 832 * MiB;
constexpr size_t OUT_YS = 33554432, OUT_KP = 34603008, OUT_VP = 34865152, OUT_SP = 35127296, OUT_KS = 39321600, OUT_VS = 43515904, OUT_SS = 47710208, OUT_END = 114819072;
constexpr int LDS_BYTES = 147456;
constexpr int NPHASE = 9;

struct Args {
    const float *xp, *xs, *ck, *cv, *s0, *norm1, *w_in, *w_a2, *b_a, *sink, *gla_norm, *p_swa, *p_gla, *w_o, *norm2, *w_up, *w_down, *fnorm;
    float* out; unsigned char* ws; int ph_lo, ph_hi;
};

__device__ __forceinline__ unsigned cvt_pk_bf16(float lo, float hi) { unsigned r; asm volatile("v_cvt_pk_bf16_f32 %0, %1, %2" : "=v"(r) : "v"(lo), "v"(hi)); return r; }
__device__ __forceinline__ bf16_t f2bf(float f) { return (bf16_t)(cvt_pk_bf16(f, 0.f) & 0xffffu); }
__device__ __forceinline__ float bf2f(unsigned h) { return __uint_as_float(h << 16); }
__device__ __forceinline__ float bflo(unsigned w) { return __uint_as_float(w << 16); }
__device__ __forceinline__ float bfhi(unsigned w) { return __uint_as_float(w & 0xffff0000u); }
__device__ __forceinline__ float wave_sum(float v) {
#pragma unroll
    for (int o = 1; o < 64; o <<= 1) v += __shfl_xor(v, o);
    return v;
}
__device__ __forceinline__ float wave_max(float v) {
#pragma unroll
    for (int o = 1; o < 64; o <<= 1) v = fmaxf(v, __shfl_xor(v, o));
    return v;
}
__device__ __forceinline__ float sigmoidf_(float x) { return 1.f / (1.f + __expf(-x)); }
__device__ __forceinline__ float sum32(const float* p) {
    f32x4 a = *(const f32x4*)p;
#pragma unroll
    for (int i = 1; i < 8; ++i) a += *(const f32x4*)(p + 4 * i);
    return (a[0] + a[1]) + (a[2] + a[3]);
}
#define MFMA_SETTLE1(a) asm volatile("s_nop 15\n\ts_nop 15" : "+v"(a))
#define MFMA_SETTLE4(a, b, c, d) asm volatile("s_nop 15\n\ts_nop 15" : "+v"(a), "+v"(b), "+v"(c), "+v"(d))
#define MFMA_SETTLE8(a, b, c, d, e, f, g, h) asm volatile("s_nop 15\n\ts_nop 15" : "+v"(a), "+v"(b), "+v"(c), "+v"(d), "+v"(e), "+v"(f), "+v"(g), "+v"(h))
#define LBAR() asm volatile("s_waitcnt lgkmcnt(0)\n\ts_barrier" ::: "memory")
#define LDS_WAIT() asm volatile("s_waitcnt lgkmcnt(0)" ::: "memory")

namespace pg8 {
constexpr int BM = 256, BK = 64, HALF = 128, HTB = HALF * BK * 2, STAGE_BYTES = 8 * HTB, NXCD = 8, WGM = 4;
__host__ __device__ __forceinline__ int lds_byte(int r, int c) { const int st = (r >> 4) * 2 + (c >> 5), rr = r & 15, cc = c & 31, ob = rr * 64 + cc * 2; return st * 1024 + (ob ^ (((ob >> 9) & 1) << 5)); }
__host__ __device__ __forceinline__ void stage_rc(int b, int& R, int& C) { const int st = b / 1024, sb = b % 1024, swz = sb ^ (((sb >> 9) & 1) << 5); R = (st >> 1) * 16 + swz / 64; C = (st & 1) * 32 + (swz % 64) / 2; }
__host__ __device__ __forceinline__ int perm32(int rho) { const int n = rho >> 4, i = rho & 15; return 8 * (i >> 2) + 4 * n + (i & 3); }
struct Unit { int pm, pn; };
struct Gemm { const bf16_t* A; const bf16_t* Bt; int M, N, K, lda, ldb; };
struct StaticOrder {
    int nM, nN, nwg, G, c;
    __host__ __device__ void init(int M_, int N_, int G_, int c_) { nM = M_ / BM; nN = N_ / BM; nwg = nM * nN; G = G_; c = c_; }
    __host__ __device__ bool next(int i, Unit& u) const {
        const long L = (long)i * G + c; if (L >= nwg) return false;
        int wgid = (int)L; { const int q = nwg / NXCD, r = nwg % NXCD, xcd = wgid % NXCD, off = wgid / NXCD; wgid = (xcd < r ? xcd * (q + 1) : r * (q + 1) + (xcd - r) * q) + off; }
        const int nig = WGM * nN, gid = wgid / nig, fm = gid * WGM, gsz = (nM - fm) < WGM ? (nM - fm) : WGM;
        u.pm = fm + ((wgid % nig) % gsz); u.pn = (wgid % nig) / gsz; return true;
    }
};

template <class Epi, class Sched>
__device__ __forceinline__ void gemm_phase(LAS unsigned char* lds, const Gemm g, const Sched& S, const Epi& E) {
    const int tid = threadIdx.x, wid = __builtin_amdgcn_readfirstlane(tid >> 6), lane = tid & 63, wr = wid >> 2, wc = wid & 3, fr = lane & 15, fq = lane >> 4;
    const int nt = g.K / BK;
    unsigned voffA[2], voffB[2];
#pragma unroll
    for (int i = 0; i < 2; ++i) { int R, C; stage_rc(tid * 16 + i * 8192, R, C); const int Rb = Epi::PERM ? ((R & ~31) + perm32(R & 31)) : R;
        voffA[i] = (unsigned)(R * g.lda + C) * 2u; voffB[i] = (unsigned)(Rb * g.ldb + C) * 2u; }
    const size_t kstep = (size_t)(BK * 2);
    const size_t hstepA = (size_t)HALF * g.lda * 2, hstepB = (size_t)HALF * g.ldb * 2;
    const size_t tstepA = 2 * hstepA, tstepB = 2 * hstepB;
    const unsigned ldsw = (unsigned)wid * 1024u;
    const int aoff = lds_byte(wr * 64 + fr, fq * 8), boff = lds_byte(wc * 32 + fr, fq * 8);
#define PG8_SA(b, h) (((b) * 2 + (h)) * HTB)
#define PG8_SB(b, h) ((4 + (b) * 2 + (h)) * HTB)
#define PG8_STAGE(bufoff, gbase, voff) do { _Pragma("unroll") for (int _i = 0; _i < 2; ++_i) \
        __builtin_amdgcn_global_load_lds((const unsigned*)((const char*)(gbase) + (voff)[_i]), (LAS unsigned*)(lds + (bufoff) + ldsw + _i * 8192), 16, 0, 0); } while (0)
#define PG8_LDA(dst, b, h) do { _Pragma("unroll") for (int m = 0; m < 4; ++m) _Pragma("unroll") for (int k = 0; k < 2; ++k) dst[m][k] = *(const LAS bf16x8*)(lds + PG8_SA(b, h) + aoff + m * 2048 + k * 1024); } while (0)
#define PG8_LDB(dst, b, h) do { _Pragma("unroll") for (int n = 0; n < 2; ++n) _Pragma("unroll") for (int k = 0; k < 2; ++k) dst[n][k] = *(const LAS bf16x8*)(lds + PG8_SB(b, h) + boff + n * 2048 + k * 1024); } while (0)
#define PG8_MMA(ai, bj, At, Bt) do { __builtin_amdgcn_s_setprio(1); _Pragma("unroll") for (int m = 0; m < 4; ++m) _Pragma("unroll") for (int n = 0; n < 2; ++n) _Pragma("unroll") for (int k = 0; k < 2; ++k) \
        acc[ai][bj][m][n] = __builtin_amdgcn_mfma_f32_16x16x32_bf16(Bt[n][k], At[m][k], acc[ai][bj][m][n], 0, 0, 0); __builtin_amdgcn_s_setprio(0); } while (0)
#define PG8_WAIT_V(n) asm volatile("s_waitcnt vmcnt(" #n ")" ::: "memory")
#define PG8_WAIT_L(n) asm volatile("s_waitcnt lgkmcnt(" #n ")" ::: "memory")
#define PG8_BAR __builtin_amdgcn_s_barrier()
#define PG8_SCHED __builtin_amdgcn_sched_barrier(0)
    Unit cur, nxt; int ui = 0;
    if (!S.next(0, cur)) return;
    f32x4 acc[2][2][4][2];
#pragma unroll
    for (int a = 0; a < 2; ++a)
#pragma unroll
        for (int b = 0; b < 2; ++b)
#pragma unroll
            for (int m = 0; m < 4; ++m)
#pragma unroll
                for (int n = 0; n < 2; ++n) acc[a][b][m][n] = (f32x4){0.f, 0.f, 0.f, 0.f};
    bf16x8 At[4][2], B0[2][2], B1[2][2];
    const char* cA = (const char*)g.A + (size_t)cur.pm * tstepA; const char* cB = (const char*)g.Bt + (size_t)cur.pn * tstepB;
    PG8_STAGE(PG8_SB(0, 0), cB, voffB); PG8_STAGE(PG8_SB(0, 1), cB + hstepB, voffB); PG8_STAGE(PG8_SA(0, 0), cA, voffA); PG8_STAGE(PG8_SA(0, 1), cA + hstepA, voffA);
    if (wr == 1) PG8_BAR;
    PG8_WAIT_V(2); PG8_BAR;
    PG8_STAGE(PG8_SB(1, 0), cB + kstep, voffB); PG8_STAGE(PG8_SA(1, 0), cA + kstep, voffA); PG8_STAGE(PG8_SB(1, 1), cB + hstepB + kstep, voffB);
    PG8_WAIT_V(6); PG8_BAR;
    for (;;) {
        const bool has_next = S.next(ui + 1, nxt);
        const char* nA = has_next ? (const char*)g.A + (size_t)nxt.pm * tstepA : cA; const char* nB = has_next ? (const char*)g.Bt + (size_t)nxt.pn * tstepB : cB;
        for (int t = 0; t < nt; t += 2) {
            const bool last = (t == nt - 2);
            const char* a1 = cA + (size_t)(t + 1) * kstep;
            const char* a2 = last ? nA : cA + (size_t)(t + 2) * kstep; const char* b2 = last ? nB : cB + (size_t)(t + 2) * kstep;
            const char* a3 = a2 + kstep; const char* b3 = b2 + kstep;
            PG8_LDB(B0, 0, 0); PG8_LDB(B1, 0, 1); PG8_SCHED; PG8_LDA(At, 0, 0); PG8_STAGE(PG8_SA(1, 1), a1 + hstepA, voffA);
            PG8_WAIT_V(8); PG8_WAIT_L(0); PG8_BAR; PG8_MMA(0, 0, At, B0); PG8_MMA(0, 1, At, B1); PG8_BAR; PG8_SCHED;
            PG8_LDA(At, 0, 1); PG8_STAGE(PG8_SB(0, 0), b2, voffB); PG8_STAGE(PG8_SB(0, 1), b2 + hstepB, voffB); PG8_STAGE(PG8_SA(0, 0), a2, voffA);
            PG8_WAIT_V(8); PG8_WAIT_L(0); PG8_BAR; PG8_MMA(1, 0, At, B0); PG8_MMA(1, 1, At, B1); PG8_BAR; PG8_SCHED;
            PG8_LDB(B0, 1, 0); PG8_LDB(B1, 1, 1); PG8_SCHED; PG8_LDA(At, 1, 0); PG8_STAGE(PG8_SA(0, 1), a2 + hstepA, voffA);
            PG8_WAIT_V(8); PG8_WAIT_L(0); PG8_BAR; PG8_MMA(0, 0, At, B0); PG8_MMA(0, 1, At, B1); PG8_BAR; PG8_SCHED;
            PG8_LDA(At, 1, 1); PG8_STAGE(PG8_SB(1, 0), b3, voffB); PG8_STAGE(PG8_SB(1, 1), b3 + hstepB, voffB); PG8_STAGE(PG8_SA(1, 0), a3, voffA);
            PG8_WAIT_V(8); PG8_WAIT_L(0); PG8_BAR; PG8_MMA(1, 0, At, B0); PG8_MMA(1, 1, At, B1); PG8_BAR; PG8_SCHED;
        }
        if (wr == 0) PG8_BAR;
        E(acc, cur, wr, wc, fr, fq);
        if (!has_next) break;
#pragma unroll
        for (int a = 0; a < 2; ++a)
#pragma unroll
            for (int b = 0; b < 2; ++b)
#pragma unroll
                for (int m = 0; m < 4; ++m)
#pragma unroll
                    for (int n = 0; n < 2; ++n) acc[a][b][m][n] = (f32x4){0.f, 0.f, 0.f, 0.f};
        cur = nxt; cA = nA; cB = nB; ++ui;
        if (wr == 1) PG8_BAR;
    }
    PG8_WAIT_V(0);
    PG8_BAR;
#undef PG8_SA
#undef PG8_SB
#undef PG8_STAGE
#undef PG8_LDA
#undef PG8_LDB
#undef PG8_MMA
#undef PG8_WAIT_V
#undef PG8_WAIT_L
#undef PG8_BAR
#undef PG8_SCHED
}

template <int ACT  > struct EpiScaleBf16 {
    static constexpr bool PERM = true;
    bf16_t* O; int ldc; const float* ss;
    __device__ __forceinline__ void operator()(const f32x4 (&acc)[2][2][4][2], const Unit& u, int wr, int wc, int fr, int fq) const {
        const int row0 = u.pm * BM + wr * 64 + fr, col0 = u.pn * BM + wc * 32 + 8 * fq;
#pragma unroll
        for (int ai = 0; ai < 2; ++ai)
#pragma unroll
            for (int m = 0; m < 4; ++m) { const int row = row0 + ai * HALF + m * 16; const float rs = ACT == 1 ? ss[row] : 1.0f;
                bf16_t* rowp = O + (size_t)row * ldc + col0;
#pragma unroll
                for (int bj = 0; bj < 2; ++bj) { f32x4 v0 = acc[ai][bj][m][0] * rs, v1 = acc[ai][bj][m][1] * rs;
                    if (ACT == 1) {
#pragma unroll
                        for (int e = 0; e < 4; ++e) { const float a0 = fmaxf(v0[e], 0.f), a1 = fmaxf(v1[e], 0.f); v0[e] = a0 * a0; v1[e] = a1 * a1; } }
                    u32x4 w; w.x = cvt_pk_bf16(v0[0], v0[1]); w.y = cvt_pk_bf16(v0[2], v0[3]); w.z = cvt_pk_bf16(v1[0], v1[1]); w.w = cvt_pk_bf16(v1[2], v1[3]);
                    *(u32x4*)(rowp + bj * HALF) = w; } }
    }
};
__device__ __forceinline__ void unpack8(const u32x4& w, float (&f)[8]) { f[0] = bflo(w.x); f[1] = bfhi(w.x); f[2] = bflo(w.y); f[3] = bfhi(w.y); f[4] = bflo(w.z); f[5] = bfhi(w.z); f[6] = bflo(w.w); f[7] = bfhi(w.w); }
struct EpiMergeA {
    static constexpr bool PERM = true;
    bf16_t* T; const bf16_t* gate; int ldg;
    __device__ __forceinline__ void operator()(const f32x4 (&acc)[2][2][4][2], const Unit& u, int wr, int wc, int fr, int fq) const {
        const int row0 = u.pm * BM + wr * 64 + fr, col0 = u.pn * BM + wc * 32 + 8 * fq;
#pragma unroll
        for (int ai = 0; ai < 2; ++ai) { u32x4 gw[4][2];
#pragma unroll
            for (int m = 0; m < 4; ++m)
#pragma unroll
                for (int bj = 0; bj < 2; ++bj) gw[m][bj] = *(const u32x4*)(gate + (size_t)(row0 + ai * HALF + m * 16) * ldg + col0 + bj * HALF);
#pragma unroll
            for (int m = 0; m < 4; ++m)
#pragma unroll
                for (int bj = 0; bj < 2; ++bj) { float g[8]; unpack8(gw[m][bj], g); const f32x4 a0 = acc[ai][bj][m][0], a1 = acc[ai][bj][m][1]; float o[8];
#pragma unroll
                    for (int e = 0; e < 4; ++e) { o[e] = a0[e] * sigmoidf_(g[e]); o[4 + e] = a1[e] * sigmoidf_(g[4 + e]); }
                    *(u32x4*)(T + (size_t)(row0 + ai * HALF + m * 16) * DM + col0 + bj * HALF) = (u32x4){cvt_pk_bf16(o[0], o[1]), cvt_pk_bf16(o[2], o[3]), cvt_pk_bf16(o[4], o[5]), cvt_pk_bf16(o[6], o[7])}; } }
    }
};
struct EpiMergeB {
    static constexpr bool PERM = true;
    const bf16_t* T; const bf16_t* gate; int ldg; bf16_t* Y;
    __device__ __forceinline__ void operator()(const f32x4 (&acc)[2][2][4][2], const Unit& u, int wr, int wc, int fr, int fq) const {
        const int row0 = u.pm * BM + wr * 64 + fr, col0 = u.pn * BM + wc * 32 + 8 * fq;
#pragma unroll
        for (int ai = 0; ai < 2; ++ai) { u32x4 gw[4][2], tw[4][2];
#pragma unroll
            for (int m = 0; m < 4; ++m)
#pragma unroll
                for (int bj = 0; bj < 2; ++bj) { const size_t r = (size_t)(row0 + ai * HALF + m * 16); gw[m][bj] = *(const u32x4*)(gate + r * ldg + col0 + bj * HALF); tw[m][bj] = *(const u32x4*)(T + r * DM + col0 + bj * HALF); }
#pragma unroll
            for (int m = 0; m < 4; ++m)
#pragma unroll
                for (int bj = 0; bj < 2; ++bj) { float g[8], t[8]; unpack8(gw[m][bj], g); unpack8(tw[m][bj], t); const f32x4 a0 = acc[ai][bj][m][0], a1 = acc[ai][bj][m][1]; float o[8];
#pragma unroll
                    for (int e = 0; e < 4; ++e) { o[e] = t[e] + a0[e] * sigmoidf_(g[e]); o[4 + e] = t[4 + e] + a1[e] * sigmoidf_(g[4 + e]); }
                    *(u32x4*)(Y + (size_t)(row0 + ai * HALF + m * 16) * DM + col0 + bj * HALF) = (u32x4){cvt_pk_bf16(o[0], o[1]), cvt_pk_bf16(o[2], o[3]), cvt_pk_bf16(o[4], o[5]), cvt_pk_bf16(o[6], o[7])}; } }
    }
};
template <bool WB> struct EpiResid {
    static constexpr bool PERM = false;
    const float* basep; const float* bases; float* out; bf16_t* ob; float* ss;
    __device__ __forceinline__ void operator()(const f32x4 (&acc)[2][2][4][2], const Unit& u, int wr, int wc, int fr, int fq) const {
        const int row0 = u.pm * BM + wr * 64 + fr, col0 = u.pn * BM + wc * 32 + 4 * fq;
#pragma unroll
        for (int ai = 0; ai < 2; ++ai)
#pragma unroll
            for (int mp = 0; mp < 2; ++mp) {
                f32x4 bv[2][4];
#pragma unroll
                for (int mm = 0; mm < 2; ++mm) { const int row = row0 + ai * HALF + (mp * 2 + mm) * 16; const float* br = row < MP ? basep + (size_t)row * DM : bases + (size_t)(row - MP) * DM;
#pragma unroll
                    for (int bj = 0; bj < 2; ++bj)
#pragma unroll
                        for (int n = 0; n < 2; ++n) bv[mm][bj * 2 + n] = *(const f32x4*)(br + col0 + bj * HALF + n * 16); }
#pragma unroll
                for (int mm = 0; mm < 2; ++mm) { const int m = mp * 2 + mm; const int row = row0 + ai * HALF + m * 16; float s = 0.f;
#pragma unroll
                    for (int bj = 0; bj < 2; ++bj)
#pragma unroll
                        for (int n = 0; n < 2; ++n) { const int col = col0 + bj * HALF + n * 16; const f32x4 o = bv[mm][bj * 2 + n] + acc[ai][bj][m][n];
                            s += (o[0] * o[0] + o[1] * o[1]) + (o[2] * o[2] + o[3] * o[3]);
                            *(f32x4*)(out + (size_t)row * DM + col) = o;
                            if (WB) { u32x2 w; w.x = cvt_pk_bf16(o[0], o[1]); w.y = cvt_pk_bf16(o[2], o[3]); *(u32x2*)(ob + (size_t)row * DM + col) = w; } }
                    s += __shfl_xor(s, 16); s += __shfl_xor(s, 32);
                    if (fq == 0) ss[(size_t)row * 32 + u.pn * 4 + wc] = s; } }
    }
};
template <int MODE> struct EpiResidB {
    static constexpr bool PERM = true;
    const float* basep; const float* bases; const bf16_t* baseb; bf16_t* ob; float* ss;
    __device__ __forceinline__ void operator()(const f32x4 (&acc)[2][2][4][2], const Unit& u, int wr, int wc, int fr, int fq) const {
        const int row0 = u.pm * BM + wr * 64 + fr, col0 = u.pn * BM + wc * 32 + 8 * fq;
#pragma unroll
        for (int ai = 0; ai < 2; ++ai) {
            f32x4 bf[MODE == 0 ? 4 : 1][2][2]; u32x4 bb[MODE == 1 ? 4 : 1][2];
#pragma unroll
            for (int m = 0; m < 4; ++m) { const int row = row0 + ai * HALF + m * 16;
                if (MODE == 0) { const float* br = row < MP ? basep + (size_t)row * DM : bases + (size_t)(row - MP) * DM;
#pragma unroll
                    for (int bj = 0; bj < 2; ++bj) { bf[MODE == 0 ? m : 0][bj][0] = *(const f32x4*)(br + col0 + bj * HALF); bf[MODE == 0 ? m : 0][bj][1] = *(const f32x4*)(br + col0 + bj * HALF + 4); } }
                else {
#pragma unroll
                    for (int bj = 0; bj < 2; ++bj) bb[MODE == 1 ? m : 0][bj] = *(const u32x4*)(baseb + (size_t)row * DM + col0 + bj * HALF); } }
#pragma unroll
            for (int m = 0; m < 4; ++m) { const int row = row0 + ai * HALF + m * 16; float s = 0.f;
#pragma unroll
                for (int bj = 0; bj < 2; ++bj) { float o[8];
                    if (MODE == 0) { const f32x4 b0 = bf[MODE == 0 ? m : 0][bj][0], b1 = bf[MODE == 0 ? m : 0][bj][1];
#pragma unroll
                        for (int e = 0; e < 4; ++e) { o[e] = b0[e] + acc[ai][bj][m][0][e]; o[4 + e] = b1[e] + acc[ai][bj][m][1][e]; } }
                    else { float t[8]; unpack8(bb[MODE == 1 ? m : 0][bj], t);
#pragma unroll
                        for (int e = 0; e < 4; ++e) { o[e] = t[e] + acc[ai][bj][m][0][e]; o[4 + e] = t[4 + e] + acc[ai][bj][m][1][e]; } }
#pragma unroll
                    for (int e = 0; e < 8; ++e) s += o[e] * o[e];
                    *(u32x4*)(ob + (size_t)row * DM + col0 + bj * HALF) = (u32x4){cvt_pk_bf16(o[0], o[1]), cvt_pk_bf16(o[2], o[3]), cvt_pk_bf16(o[4], o[5]), cvt_pk_bf16(o[6], o[7])}; }
                s += __shfl_xor(s, 16); s += __shfl_xor(s, 32);
                if (fq == 0) ss[(size_t)row * 32 + u.pn * 4 + wc] = s; } }
    }
};
}

template <int MODE  >
__device__ __forceinline__ void transpose_item(const float* W, int K, int N, bf16_t* WT, int ldt, int koff, const float* ks, float* scr, int item, int lane) {
    const int nblk = (N + 31) / 32, kb = item / nblk, nb = item % nblk, k0 = 64 * kb, n0 = 32 * nb;
    const int nn = n0 + (lane & 31);
    float v[32]; const float* wp = W + (size_t)(k0 + (lane >> 5)) * N + nn; const bool nok = nn < N;
#pragma unroll
    for (int i = 0; i < 32; ++i) v[i] = nok ? wp[(size_t)(2 * i) * N] : 0.f;
#pragma unroll
    for (int i = 0; i < 32; ++i) { const int kk = 2 * i + (lane >> 5); float x = v[i]; if (MODE != 0) x *= ks[k0 + kk]; scr[kk * 33 + (lane & 31)] = x; }
    LDS_WAIT(); asm volatile("" ::: "memory");
    const int c = lane & 7;
#pragma unroll
    for (int j = 0; j < 4; ++j) { const int nl = (lane >> 3) + 8 * j, n = n0 + nl; const float* s = scr + (8 * c) * 33 + nl;
        u32x4 o; o.x = cvt_pk_bf16(s[0 * 33], s[1 * 33]); o.y = cvt_pk_bf16(s[2 * 33], s[3 * 33]); o.z = cvt_pk_bf16(s[4 * 33], s[5 * 33]); o.w = cvt_pk_bf16(s[6 * 33], s[7 * 33]);
        int dst = n; if (MODE == 1) dst = n < 7680 ? n : (n < 7696 ? ZAG + (n - 7680) : n - 16);
        if (n < N) *(u32x4*)(WT + (size_t)dst * ldt + koff + k0 + 8 * c) = o; }
    LDS_WAIT(); asm volatile("" ::: "memory");
}

__device__ __forceinline__ void phase0(const Args& a, unsigned char* lds, int tid) {
    const int lane = tid & 63, wave = tid >> 6, G = gridDim.x;
    const int gw = blockIdx.x * 8 + wave, NGW = G * 8, gt = blockIdx.x * 512 + tid, GT = G * 512;
    float* scr = (float*)(lds + wave * 8704);
    unsigned char* ws = a.ws;
    bf16_t* WIN = (bf16_t*)(ws + WS_WIN); bf16_t* PCAT = (bf16_t*)(ws + WS_PCAT); bf16_t* WO = (bf16_t*)(ws + WS_WO); bf16_t* WUP = (bf16_t*)(ws + WS_WUP); bf16_t* WDN = (bf16_t*)(ws + WS_WDN);
    constexpr int I_IN = 32 * 369, I_PS = 16 * 64, I_PG = 32 * 64, I_WO = 32 * 64, I_UP = 32 * 256, I_DN = 128 * 64;
    constexpr int NIT = I_IN + I_PS + I_PG + I_WO + I_UP + I_DN;
    for (int it = gw; it < NIT; it += NGW) {
        int r = it;
        if (r < I_IN) { transpose_item<1>(a.w_in, DM, DIN, WIN, DM, 0, a.norm1, scr, r, lane); continue; } r -= I_IN;
        if (r < I_PS) { transpose_item<0>(a.p_swa, 1024, DM, PCAT, OC, 0, nullptr, scr, r, lane); continue; } r -= I_PS;
        if (r < I_PG) { transpose_item<0>(a.p_gla, DM, DM, PCAT, OC, 1024, nullptr, scr, r, lane); continue; } r -= I_PG;
        if (r < I_WO) { transpose_item<0>(a.w_o, DM, DM, WO, DM, 0, nullptr, scr, r, lane); continue; } r -= I_WO;
        if (r < I_UP) { transpose_item<2>(a.w_up, DM, DFF, WUP, DM, 0, a.norm2, scr, r, lane); continue; } r -= I_UP;
        transpose_item<0>(a.w_down, DFF, DM, WDN, DFF, 0, nullptr, scr, r, lane);
    }
    float* SS1 = (float*)(ws + WS_SS1); bf16_t* XB = (bf16_t*)(ws + WS_XB);
    for (int m = gw; m < M; m += NGW) {
        const float* xr = m < MP ? a.xp + (size_t)m * DM : a.xs + (size_t)(m - MP) * DM;
        f32x4 v[8]; float s = 0.f;
#pragma unroll
        for (int j = 0; j < 8; ++j) { v[j] = ((const f32x4*)xr)[lane + 64 * j]; s += (v[j][0] * v[j][0] + v[j][1] * v[j][1]) + (v[j][2] * v[j][2] + v[j][3] * v[j][3]); }
        s = wave_sum(s); const float rs1 = rsqrtf(s * (1.0f / DM) + EPS);
        u32x2* o = (u32x2*)(XB + (size_t)m * DM);
#pragma unroll
        for (int j = 0; j < 8; ++j) { u32x2 w; w.x = cvt_pk_bf16(v[j][0] * rs1, v[j][1] * rs1); w.y = cvt_pk_bf16(v[j][2] * rs1, v[j][3] * rs1); o[lane + 64 * j] = w; }
    }
    { u32x4* p = (u32x4*)(WIN + (size_t)DIN * DM); for (int i = gt; i < (DINP - DIN) * DM * 2 / 16; i += GT) p[i] = (u32x4){0u, 0u, 0u, 0u}; }
    { f32x2* R = (f32x2*)(ws + WS_ROPE);
      for (int i = gt; i < 2052 * 8; i += GT) { const int p = i >> 3, e = i & 7; const int pos = p < 2048 ? p : 8192 + (p - 2048);
          const float inv = exp2f(-(float)e * 2.3664460711655217f); const float ang = (float)pos * inv; float sn, cs; sincosf(ang, &sn, &cs); R[i] = (f32x2){cs, sn}; } }
}

__device__ __forceinline__ float logsig16(float g) { return (fminf(g, 0.f) - __logf(1.f + __expf(-fabsf(g)))) * 0.0625f; }

constexpr size_t WS_QIG = WS_Y, WS_KDG = WS_Y + 32 * MiB, WS_AMG = WS_Y + 64 * MiB, WS_DECG = WS_Y + 68 * MiB;
__device__ __forceinline__ void gla_pre_items(const Args& a, unsigned char* lds, int first, int count, int tid) {
    const int lane = tid & 63, wave = tid >> 6, r16 = lane & 15, q4 = lane >> 4;
    unsigned char* QI = lds; unsigned char* KI = lds + 16896; unsigned char* AGB = lds + 95744; float* LA = (float*)(lds + 99328);
    const bf16_t* Z = (const bf16_t*)(a.ws + WS_Z);
    bf16_t* QIg = (bf16_t*)(a.ws + WS_QIG); bf16_t* KDg = (bf16_t*)(a.ws + WS_KDG); bf16_t* AMg = (bf16_t*)(a.ws + WS_AMG); float* DECg = (float*)(a.ws + WS_DECG);
    const int kcol = tid & 255, half = tid >> 8;
    u32x4 rq[2], rk[2], rag = (u32x4){0u, 0u, 0u, 0u};
#define PRE_LOAD(item_) do { const int bh_ = (item_) >> 6, n_ = (item_) & 63, h_ = bh_ & 3; const size_t r0_ = (size_t)(bh_ >> 2) * 2048 + (size_t)n_ * 32; _Pragma("unroll") for (int i_ = 0; i_ < 2; ++i_) { const int ch_ = tid + i_ * 512, rr_ = ch_ >> 5, cc_ = ch_ & 31; \
        rq[i_] = *(const u32x4*)(Z + (r0_ + rr_) * DINP + ZQG + h_ * 256 + cc_ * 8); rk[i_] = *(const u32x4*)(Z + (r0_ + rr_) * DINP + ZKG + h_ * 256 + cc_ * 8); } \
        if (tid < 64) rag = *(const u32x4*)(Z + (r0_ + (tid >> 1)) * DINP + ZAG + (tid & 1) * 8); } while (0)
    PRE_LOAD(first);
    for (int it = 0; it < count; ++it) {
        const int item = first + it, h = (item >> 6) & 3;
        bf16x8 wfr[2]; float bak[2];
#pragma unroll
        for (int t2 = 0; t2 < 2; ++t2) { const int kc = h * 256 + (wave * 2 + t2) * 16 + r16; bak[t2] = a.b_a[kc]; unsigned pk[4];
#pragma unroll
            for (int i = 0; i < 8; i += 2) { float w2[2];
#pragma unroll
                for (int e = 0; e < 2; ++e) { const int r = (q4 & 1) * 8 + i + e; const float wf = a.w_a2[r * 1024 + kc]; const float whi = bf2f(f2bf(wf)); w2[e] = (q4 < 2) ? whi : (wf - whi); }
                pk[i >> 1] = cvt_pk_bf16(w2[0], w2[1]); }
            wfr[t2] = __builtin_bit_cast(bf16x8, (u32x4){pk[0], pk[1], pk[2], pk[3]}); }
#pragma unroll
        for (int i = 0; i < 2; ++i) { const int ch = tid + i * 512, rr = ch >> 5, cc = ch & 31; *(u32x4*)(QI + rr * 528 + cc * 16) = rq[i]; *(u32x4*)(KI + rr * 528 + cc * 16) = rk[i]; }
        if (tid < 64) { unsigned char* d = AGB + (tid >> 1) * 80 + (tid & 1) * 16; *(u32x4*)d = rag; *(u32x4*)(d + 32) = rag; }
        if (it + 1 < count) PRE_LOAD(item + 1);
        LBAR();
#pragma unroll
        for (int lt2 = 0; lt2 < 2; ++lt2) { const bf16x8 agf = *(const bf16x8*)(AGB + (lt2 * 16 + r16) * 80 + q4 * 16);
#pragma unroll
            for (int t2 = 0; t2 < 2; ++t2) { f32x4 g4 = __builtin_amdgcn_mfma_f32_16x16x32_bf16(agf, wfr[t2], (f32x4){0.f, 0.f, 0.f, 0.f}, 0, 0, 0);
#pragma unroll
                for (int j = 0; j < 4; ++j) LA[(lt2 * 16 + q4 * 4 + j) * 260 + (wave * 2 + t2) * 16 + r16] = logsig16(g4[j] + bak[t2]); } }
        LBAR();
        { float bl[16]; float blast;
          { float run = 0.f;
#pragma unroll
            for (int l = 0; l < 32; ++l) { run += LA[l * 260 + kcol]; if ((l >> 4) == half) bl[l & 15] = run; }
            blast = run; }
          const float dec = __expf(blast);
          if (half == 0) DECg[(size_t)item * 256 + kcol] = dec;
          unsigned kdp[8];
#pragma unroll
          for (int i = 0; i < 16; i += 2) { float kd2[2];
#pragma unroll
              for (int e = 0; e < 2; ++e) { const int l = half * 16 + i + e; const float bb = bl[i + e];
                  const float eq = __expf(bb) * 0.0625f, ek = __expf(-bb), ed = dec * ek;
                  bf16_t* qp = (bf16_t*)(QI + l * 528) + kcol; bf16_t* kp = (bf16_t*)(KI + l * 528) + kcol;
                  const float qv = bf2f(*qp), kv = bf2f(*kp); *qp = f2bf(qv * eq); *kp = f2bf(kv * ek); kd2[e] = kv * ed; }
              kdp[i >> 1] = cvt_pk_bf16(kd2[0], kd2[1]); }
          u32x4* kg = (u32x4*)(KDg + ((size_t)item * 256 + kcol) * 32 + half * 16); kg[0] = (u32x4){kdp[0], kdp[1], kdp[2], kdp[3]}; kg[1] = (u32x4){kdp[4], kdp[5], kdp[6], kdp[7]}; }
        LBAR();
        if (wave < 4) { const int lt2 = (wave == 1 || wave == 2) ? 1 : 0, mt = (wave >= 2) ? 1 : 0;
            f32x4 aacc = (f32x4){0.f, 0.f, 0.f, 0.f};
            if (wave < 3) {
#pragma unroll
                for (int kk = 0; kk < 8; ++kk) { const bf16x8 af = *(const bf16x8*)(KI + (mt * 16 + r16) * 528 + kk * 64 + q4 * 16); const bf16x8 bfg = *(const bf16x8*)(QI + (lt2 * 16 + r16) * 528 + kk * 64 + q4 * 16);
                    aacc = __builtin_amdgcn_mfma_f32_16x16x32_bf16(af, bfg, aacc, 0, 0, 0); } }
            const int l = lt2 * 16 + r16, m0 = mt * 16 + q4 * 4; float v4[4];
#pragma unroll
            for (int j = 0; j < 4; ++j) v4[j] = (m0 + j <= l) ? aacc[j] : 0.f;
            *(u32x2*)(AMg + ((size_t)item * 32 + l) * 32 + m0) = (u32x2){cvt_pk_bf16(v4[0], v4[1]), cvt_pk_bf16(v4[2], v4[3])}; }
#pragma unroll
        for (int i = 0; i < 2; ++i) { const int ch = tid + i * 512, rr = ch >> 5, cc = ch & 31; *(u32x4*)(QIg + ((size_t)item * 32 + rr) * 256 + cc * 8) = *(const u32x4*)(QI + rr * 528 + cc * 16); }
        LBAR();
    }
    __syncthreads();
#undef PRE_LOAD
}

__device__ __forceinline__ void gla_prompt_unit(const Args& a, unsigned char* lds, int unit, int tid) {
    const int lane = tid & 63, wave = tid >> 6, r16 = lane & 15, q4 = lane >> 4;
    const int bh = unit >> 3, vs = unit & 7, b = bh >> 2, h = bh & 3;
    unsigned char* QI = lds; unsigned char* KDT = lds + 33792; unsigned char* ST = lds + 54272;
    unsigned char* VT = lds + 88064; unsigned char* AM = lds + 93184; float* DEC = (float*)(lds + 98304);
    const bf16_t* Z = (const bf16_t*)(a.ws + WS_Z); bf16_t* OCAT = (bf16_t*)(a.ws + WS_OCAT); float* GSS = (float*)(a.ws + WS_GSSP);
    const bf16_t* QIg = (const bf16_t*)(a.ws + WS_QIG); const bf16_t* KDg = (const bf16_t*)(a.ws + WS_KDG); const bf16_t* AMg = (const bf16_t*)(a.ws + WS_AMG); const float* DECg = (const float*)(a.ws + WS_DECG);
    for (int i = tid; i < 33792 / 16; i += 512) ((u32x4*)ST)[i] = (u32x4){0u, 0u, 0u, 0u};
    f32x4 sacc[2][4];
#pragma unroll
    for (int i = 0; i < 2; ++i)
#pragma unroll
        for (int j = 0; j < 4; ++j) sacc[i][j] = (f32x4){0.f, 0.f, 0.f, 0.f};
    const size_t rowbase = (size_t)b * 2048;
    u32x4 rq[2], rkd[2], rv = (u32x4){0u, 0u, 0u, 0u}, ram = (u32x4){0u, 0u, 0u, 0u}, rdec = (u32x4){0u, 0u, 0u, 0u};
#define GLA_LOAD(n) do { const size_t it_ = (size_t)bh * 64 + (n); _Pragma("unroll") for (int i_ = 0; i_ < 2; ++i_) { const int ch_ = tid + i_ * 512; \
        rq[i_] = *(const u32x4*)(QIg + it_ * 8192 + (size_t)ch_ * 8); rkd[i_] = *(const u32x4*)(KDg + it_ * 8192 + (size_t)ch_ * 8); } \
        if (tid < 128) ram = *(const u32x4*)(AMg + it_ * 1024 + tid * 8); \
        if (tid >= 128 && tid < 192) rdec = *(const u32x4*)(DECg + it_ * 256 + (tid - 128) * 4); \
        if (tid >= 256) rv = *(const u32x4*)(Z + (rowbase + (size_t)(n) * 32 + (tid & 31)) * DINP + ZVG + h * 512 + vs * 64 + ((tid - 256) >> 5) * 8); } while (0)
    GLA_LOAD(0);
    for (int n = 0; n < 64; ++n) {
        const size_t row0 = rowbase + (size_t)n * 32;
#pragma unroll
        for (int i = 0; i < 2; ++i) { const int ch = tid + i * 512; *(u32x4*)(QI + (ch >> 5) * 528 + (ch & 31) * 16) = rq[i]; *(u32x4*)(KDT + (ch >> 2) * 80 + (ch & 3) * 16) = rkd[i]; }
        if (tid < 128) *(u32x4*)(AM + (tid >> 2) * 80 + (tid & 3) * 16) = ram;
        if (tid >= 128 && tid < 192) *(u32x4*)(DEC + (tid - 128) * 4) = rdec;
        if (tid >= 256) { const int l = tid & 31, c8 = (tid - 256) >> 5; bf16_t* vt = (bf16_t*)VT + (c8 * 8) * 40 + l;
            vt[0 * 40] = (bf16_t)(rv.x & 0xffffu); vt[1 * 40] = (bf16_t)(rv.x >> 16); vt[2 * 40] = (bf16_t)(rv.y & 0xffffu); vt[3 * 40] = (bf16_t)(rv.y >> 16);
            vt[4 * 40] = (bf16_t)(rv.z & 0xffffu); vt[5 * 40] = (bf16_t)(rv.z >> 16); vt[6 * 40] = (bf16_t)(rv.w & 0xffffu); vt[7 * 40] = (bf16_t)(rv.w >> 16); }
        if (n + 1 < 64) GLA_LOAD(n + 1);
        LBAR();
        const int vt = wave & 3, lt = wave >> 2;
        f32x4 oacc = (f32x4){0.f, 0.f, 0.f, 0.f};
#pragma unroll
        for (int kk = 0; kk < 8; ++kk) { const bf16x8 af = *(const bf16x8*)(ST + (vt * 16 + r16) * 528 + kk * 64 + q4 * 16); const bf16x8 bfg = *(const bf16x8*)(QI + (lt * 16 + r16) * 528 + kk * 64 + q4 * 16);
            oacc = __builtin_amdgcn_mfma_f32_16x16x32_bf16(af, bfg, oacc, 0, 0, 0); }
        { const bf16x8 af = *(const bf16x8*)(VT + (vt * 16 + r16) * 80 + q4 * 16); const bf16x8 bfg = *(const bf16x8*)(AM + (lt * 16 + r16) * 80 + q4 * 16);
          oacc = __builtin_amdgcn_mfma_f32_16x16x32_bf16(af, bfg, oacc, 0, 0, 0);
          MFMA_SETTLE1(oacc);
          const size_t row = row0 + lt * 16 + r16;
          *(u32x2*)(OCAT + row * OC + 1024 + h * 512 + vs * 64 + vt * 16 + q4 * 4) = (u32x2){cvt_pk_bf16(oacc[0], oacc[1]), cvt_pk_bf16(oacc[2], oacc[3])};
          float ss = (oacc[0] * oacc[0] + oacc[1] * oacc[1]) + (oacc[2] * oacc[2] + oacc[3] * oacc[3]); ss += __shfl_xor(ss, 16); ss += __shfl_xor(ss, 32);
          if (lane < 16) GSS[(row * 4 + h) * 32 + vs * 4 + vt] = ss; }
        LBAR();
#pragma unroll
        for (int k2 = 0; k2 < 2; ++k2) { const int kt = wave * 2 + k2; const f32x4 dec4 = *(const f32x4*)(DEC + kt * 16 + q4 * 4); const bf16x8 af = *(const bf16x8*)(KDT + (kt * 16 + r16) * 80 + q4 * 16);
#pragma unroll
            for (int v2 = 0; v2 < 4; ++v2) { const bf16x8 bfg = *(const bf16x8*)(VT + (v2 * 16 + r16) * 80 + q4 * 16);
                sacc[k2][v2] = __builtin_amdgcn_mfma_f32_16x16x32_bf16(af, bfg, sacc[k2][v2] * dec4, 0, 0, 0); } }
        MFMA_SETTLE8(sacc[0][0], sacc[0][1], sacc[0][2], sacc[0][3], sacc[1][0], sacc[1][1], sacc[1][2], sacc[1][3]);
#pragma unroll
        for (int k2 = 0; k2 < 2; ++k2) { const int kt = wave * 2 + k2;
#pragma unroll
            for (int v2 = 0; v2 < 4; ++v2)
                *(u32x2*)(ST + (v2 * 16 + r16) * 528 + (kt * 16 + q4 * 4) * 2) = (u32x2){cvt_pk_bf16(sacc[k2][v2][0], sacc[k2][v2][1]), cvt_pk_bf16(sacc[k2][v2][2], sacc[k2][v2][3])}; }
        LBAR();
    }
    float* SP = a.out + OUT_SP + (size_t)bh * 256 * 512;
#pragma unroll
    for (int k2 = 0; k2 < 2; ++k2)
#pragma unroll
        for (int v2 = 0; v2 < 4; ++v2)
#pragma unroll
            for (int j = 0; j < 4; ++j) SP[(size_t)((wave * 2 + k2) * 16 + q4 * 4 + j) * 512 + vs * 64 + v2 * 16 + r16] = sacc[k2][v2][j];
    __syncthreads();
#undef GLA_LOAD
}

__device__ __forceinline__ void swa_prompt_unit(const Args& a, unsigned char* lds, int unit, int tid) {
    const int lane = tid & 63, wave = tid >> 6, r16 = lane & 15, q4 = lane >> 4;
    const int kvh = unit & 3, blk = (unit >> 2) & 15, b = unit >> 6;
    unsigned char* KL = lds; unsigned char* VTL = lds + 36864;
    const bf16_t* Z = (const bf16_t*)(a.ws + WS_Z); bf16_t* OCAT = (bf16_t*)(a.ws + WS_OCAT); const f32x2* ROPE = (const f32x2*)(a.ws + WS_ROPE);
#pragma unroll
    for (int it = 0; it < 4; ++it) { const int e = tid + it * 512, j = e >> 3, c = e & 7; const int kpos = (blk - 1) * 128 + j; const bool valid = kpos >= 0;
        const size_t row = (size_t)b * 2048 + (valid ? kpos : 0);
        u32x4 raw = (u32x4){0u, 0u, 0u, 0u}, rawv = (u32x4){0u, 0u, 0u, 0u}; float kf[8];
        if (valid) { raw = *(const u32x4*)(Z + row * DINP + ZKS + kvh * 64 + c * 8); rawv = *(const u32x4*)(Z + row * DINP + ZVS + kvh * 64 + c * 8); }
        kf[0] = bflo(raw.x); kf[1] = bfhi(raw.x); kf[2] = bflo(raw.y); kf[3] = bfhi(raw.y); kf[4] = bflo(raw.z); kf[5] = bfhi(raw.z); kf[6] = bflo(raw.w); kf[7] = bfhi(raw.w);
        if (c < 2 && valid) { const u32x4 pr = *(const u32x4*)(Z + row * DINP + ZKS + kvh * 64 + (c ^ 1) * 8);
            float pf[8]; pf[0] = bflo(pr.x); pf[1] = bfhi(pr.x); pf[2] = bflo(pr.y); pf[3] = bfhi(pr.y); pf[4] = bflo(pr.z); pf[5] = bfhi(pr.z); pf[6] = bflo(pr.w); pf[7] = bfhi(pr.w);
            const f32x2* rp = ROPE + kpos * 8; const float sg = c == 0 ? -1.f : 1.f;
#pragma unroll
            for (int d = 0; d < 8; ++d) { const f32x2 cs = rp[d]; kf[d] = kf[d] * cs.x + sg * pf[d] * cs.y; }
            raw.x = cvt_pk_bf16(kf[0], kf[1]); raw.y = cvt_pk_bf16(kf[2], kf[3]); raw.z = cvt_pk_bf16(kf[4], kf[5]); raw.w = cvt_pk_bf16(kf[6], kf[7]);
            kf[0] = bflo(raw.x); kf[1] = bfhi(raw.x); kf[2] = bflo(raw.y); kf[3] = bfhi(raw.y); kf[4] = bflo(raw.z); kf[5] = bfhi(raw.z); kf[6] = bflo(raw.w); kf[7] = bfhi(raw.w); }
        *(u32x4*)(KL + j * 144 + c * 16) = raw;
        bf16_t* vt = (bf16_t*)VTL + (c * 8) * 264 + j;
        vt[0 * 264] = (bf16_t)(rawv.x & 0xffffu); vt[1 * 264] = (bf16_t)(rawv.x >> 16); vt[2 * 264] = (bf16_t)(rawv.y & 0xffffu); vt[3 * 264] = (bf16_t)(rawv.y >> 16);
        vt[4 * 264] = (bf16_t)(rawv.z & 0xffffu); vt[5 * 264] = (bf16_t)(rawv.z >> 16); vt[6 * 264] = (bf16_t)(rawv.w & 0xffffu); vt[7 * 264] = (bf16_t)(rawv.w >> 16);
        if (blk == 15 && j >= 128) { const size_t o = ((size_t)(b * 128 + (j - 128)) * 4 + kvh) * 64 + c * 8;
            *(f32x4*)(a.out + OUT_KP + o) = (f32x4){kf[0], kf[1], kf[2], kf[3]}; *(f32x4*)(a.out + OUT_KP + o + 4) = (f32x4){kf[4], kf[5], kf[6], kf[7]};
            *(f32x4*)(a.out + OUT_VP + o) = (f32x4){bflo(rawv.x), bfhi(rawv.x), bflo(rawv.y), bfhi(rawv.y)}; *(f32x4*)(a.out + OUT_VP + o + 4) = (f32x4){bflo(rawv.z), bfhi(rawv.z), bflo(rawv.w), bfhi(rawv.w)}; } }
    __syncthreads();
    const int g = wave >> 1; const float sk = a.sink[kvh * 4 + g];
    for (int qt = 0; qt < 4; ++qt) {
        const int q0 = (wave & 1) * 64 + qt * 16, qi = q0 + r16, qpos = blk * 128 + qi; const size_t row = (size_t)b * 2048 + qpos;
        bf16x8 qf[2];
#pragma unroll
        for (int kk = 0; kk < 2; ++kk) { const int c = kk * 4 + q4; const bf16_t* qp = Z + row * DINP + ZQS + (kvh * 4 + g) * 64;
            const u32x4 raw = *(const u32x4*)(qp + c * 8); float f[8];
            f[0] = bflo(raw.x); f[1] = bfhi(raw.x); f[2] = bflo(raw.y); f[3] = bfhi(raw.y); f[4] = bflo(raw.z); f[5] = bfhi(raw.z); f[6] = bflo(raw.w); f[7] = bfhi(raw.w);
            if (kk == 0 && q4 < 2) { const u32x4 pr = *(const u32x4*)(qp + (c ^ 1) * 8);
                float pf[8]; pf[0] = bflo(pr.x); pf[1] = bfhi(pr.x); pf[2] = bflo(pr.y); pf[3] = bfhi(pr.y); pf[4] = bflo(pr.z); pf[5] = bfhi(pr.z); pf[6] = bflo(pr.w); pf[7] = bfhi(pr.w);
                const f32x2* rp = ROPE + qpos * 8; const float sg = c == 0 ? -1.f : 1.f;
#pragma unroll
                for (int d = 0; d < 8; ++d) { const f32x2 cs = rp[d]; f[d] = f[d] * cs.x + sg * pf[d] * cs.y; } }
            u32x4 w; w.x = cvt_pk_bf16(f[0] * 0.125f, f[1] * 0.125f); w.y = cvt_pk_bf16(f[2] * 0.125f, f[3] * 0.125f); w.z = cvt_pk_bf16(f[4] * 0.125f, f[5] * 0.125f); w.w = cvt_pk_bf16(f[6] * 0.125f, f[7] * 0.125f);
            asm volatile("s_nop 4" : "+v"(w));
            qf[kk] = __builtin_bit_cast(bf16x8, w); }
        const int t0 = (wave & 1) * 4 + qt;
        f32x4 sc[16];
#pragma unroll
        for (int t = 0; t < 16; ++t) { sc[t] = (f32x4){0.f, 0.f, 0.f, 0.f};
            if (t >= t0 && t <= t0 + 8) {
#pragma unroll
                for (int kk = 0; kk < 2; ++kk) { const bf16x8 af = *(const bf16x8*)(KL + (t * 16 + r16) * 144 + kk * 64 + q4 * 16); sc[t] = __builtin_amdgcn_mfma_f32_16x16x32_bf16(af, qf[kk], sc[t], 0, 0, 0); } } }
        float mx = -3.0e38f;
#pragma unroll
        for (int t = 0; t < 16; ++t) if (t >= t0 && t <= t0 + 8) {
#pragma unroll
            for (int j = 0; j < 4; ++j) { const int key = t * 16 + q4 * 4 + j; const bool ok = key > qi && key <= qi + 128 && (blk > 0 || key >= 128); if (ok) mx = fmaxf(mx, sc[t][j]); } }
        mx = fmaxf(mx, __shfl_xor(mx, 16)); mx = fmaxf(mx, __shfl_xor(mx, 32)); mx = fmaxf(mx, sk);
        float sum = 0.f;
#pragma unroll
        for (int t = 0; t < 16; ++t) { if (t >= t0 && t <= t0 + 8) {
#pragma unroll
            for (int j = 0; j < 4; ++j) { const int key = t * 16 + q4 * 4 + j; const bool ok = key > qi && key <= qi + 128 && (blk > 0 || key >= 128); const float p = ok ? __expf(sc[t][j] - mx) : 0.f; sc[t][j] = p; sum += p; } }
            else sc[t] = (f32x4){0.f, 0.f, 0.f, 0.f}; }
        sum += __shfl_xor(sum, 16); sum += __shfl_xor(sum, 32);
        const float inv = 1.f / (sum + __expf(sk - mx));
        f32x4 oacc[4];
#pragma unroll
        for (int dt = 0; dt < 4; ++dt) oacc[dt] = (f32x4){0.f, 0.f, 0.f, 0.f};
#pragma unroll
        for (int i = 0; i < 8; ++i) if (2 * i + 1 >= t0 && 2 * i <= t0 + 8) { u32x4 w; w.x = cvt_pk_bf16(sc[2 * i][0] * inv, sc[2 * i][1] * inv); w.y = cvt_pk_bf16(sc[2 * i][2] * inv, sc[2 * i][3] * inv);
            w.z = cvt_pk_bf16(sc[2 * i + 1][0] * inv, sc[2 * i + 1][1] * inv); w.w = cvt_pk_bf16(sc[2 * i + 1][2] * inv, sc[2 * i + 1][3] * inv);
            asm volatile("s_nop 4" : "+v"(w));
            const bf16x8 pf = __builtin_bit_cast(bf16x8, w);
#pragma unroll
            for (int dt = 0; dt < 4; ++dt) { const unsigned char* vp = VTL + (dt * 16 + r16) * 528 + ((2 * i) * 16 + q4 * 4) * 2;
                const u32x2 lo = *(const u32x2*)vp, hi = *(const u32x2*)(vp + 32); const bf16x8 af = __builtin_bit_cast(bf16x8, (u32x4){lo.x, lo.y, hi.x, hi.y});
                oacc[dt] = __builtin_amdgcn_mfma_f32_16x16x32_bf16(af, pf, oacc[dt], 0, 0, 0); } }
        MFMA_SETTLE4(oacc[0], oacc[1], oacc[2], oacc[3]);
#pragma unroll
        for (int dt = 0; dt < 4; ++dt) *(u32x2*)(OCAT + row * OC + (kvh * 4 + g) * 64 + dt * 16 + q4 * 4) = (u32x2){cvt_pk_bf16(oacc[dt][0], oacc[dt][1]), cvt_pk_bf16(oacc[dt][2], oacc[dt][3])};
    }
    __syncthreads();
}

__device__ __forceinline__ void gla_sample_unit(const Args& a, unsigned char* lds, int unit, int tid) {
    const int lane = tid & 63, wave = tid >> 6;
    const int b = unit >> 2, h = unit & 3;
    float* Q4 = (float*)lds;
    float* KD4 = Q4 + 1024;
    float* KI4 = KD4 + 1024;
    float* DECS = KI4 + 1024;
    float* AS = DECS + 256;
    float* RED = AS + 16;
    float* VS = RED + 16;
    float* ORED = VS + 2048;
    const bf16_t* Z = (const bf16_t*)(a.ws + WS_Z); bf16_t* OCAT = (bf16_t*)(a.ws + WS_OCAT);
    const size_t row0 = (size_t)MP + b * 4;
    if (tid < 256) { const int kcol = tid; float la[4];
#pragma unroll
        for (int t = 0; t < 4; ++t) la[t] = a.b_a[h * 256 + kcol];
#pragma unroll
        for (int r = 0; r < 16; ++r) { const float w = a.w_a2[r * 1024 + h * 256 + kcol];
#pragma unroll
            for (int t = 0; t < 4; ++t) la[t] += bf2f(Z[(row0 + t) * DINP + ZAG + r]) * w; }
        float bb[4]; float c = 0.f;
#pragma unroll
        for (int t = 0; t < 4; ++t) { c += logsig16(la[t]); bb[t] = c; }
        f32x4 qv, kd, ki;
#pragma unroll
        for (int t = 0; t < 4; ++t) { const float q = bf2f(Z[(row0 + t) * DINP + ZQG + h * 256 + kcol]), k = bf2f(Z[(row0 + t) * DINP + ZKG + h * 256 + kcol]);
            qv[t] = q * __expf(bb[t]) * 0.0625f; ki[t] = k * __expf(-bb[t]); kd[t] = k * __expf(c - bb[t]); }
        *(f32x4*)(Q4 + kcol * 4) = qv; *(f32x4*)(KD4 + kcol * 4) = kd; *(f32x4*)(KI4 + kcol * 4) = ki; DECS[kcol] = __expf(c);
    } else { const int j = tid - 256, t = j >> 6, c = j & 63; const u32x4 raw = *(const u32x4*)(Z + (row0 + t) * DINP + ZVG + h * 512 + c * 8);
        float* d = VS + t * 512 + c * 8; *(f32x4*)d = (f32x4){bflo(raw.x), bfhi(raw.x), bflo(raw.y), bfhi(raw.y)}; *(f32x4*)(d + 4) = (f32x4){bflo(raw.z), bfhi(raw.z), bflo(raw.w), bfhi(raw.w)}; }
    __syncthreads();
    { const int pair = tid >> 5, sub = tid & 31, t = pair >> 2, m = pair & 3; float s = 0.f;
#pragma unroll
      for (int i = 0; i < 8; ++i) { const int k = sub + 32 * i; s += Q4[k * 4 + t] * KI4[k * 4 + m]; }
#pragma unroll
      for (int o = 1; o < 32; o <<= 1) s += __shfl_xor(s, o);
      if (sub == 0) AS[t * 4 + m] = (m <= t) ? s : 0.f; }
    const int kq = tid >> 7, vc = (tid & 127) * 4;
    f32x4 vr[4], o[4];
#pragma unroll
    for (int t = 0; t < 4; ++t) { vr[t] = *(const f32x4*)(VS + t * 512 + vc); o[t] = (f32x4){0.f, 0.f, 0.f, 0.f}; }
    const float* S0 = a.s0 + (size_t)unit * 256 * 512; float* SN = a.out + OUT_SS + (size_t)unit * 256 * 512;
    f32x4 sb[2][8];
#pragma unroll
    for (int i = 0; i < 8; ++i) sb[0][i] = *(const f32x4*)(S0 + (size_t)(i * 4 + kq) * 512 + vc);
#pragma unroll
    for (int g = 0; g < 8; ++g) {
        if (g + 1 < 8) {
#pragma unroll
            for (int i = 0; i < 8; ++i) sb[(g + 1) & 1][i] = *(const f32x4*)(S0 + (size_t)(((g + 1) * 8 + i) * 4 + kq) * 512 + vc); }
#pragma unroll
        for (int i = 0; i < 8; ++i) { const int k = (g * 8 + i) * 4 + kq; const f32x4 s = sb[g & 1][i];
            const f32x4 qv = *(const f32x4*)(Q4 + k * 4), kd = *(const f32x4*)(KD4 + k * 4); const float dec = DECS[k];
            f32x4 sn = s * dec;
#pragma unroll
            for (int t = 0; t < 4; ++t) { sn += vr[t] * kd[t]; o[t] += s * qv[t]; }
            *(f32x4*)(SN + (size_t)k * 512 + vc) = sn; } }
#pragma unroll
    for (int t = 0; t < 4; ++t) *(f32x4*)(ORED + (kq * 4 + t) * 512 + vc) = o[t];
    __syncthreads();
    { const int t = tid >> 7, v4 = (tid & 127) * 4; f32x4 ov = (f32x4){0.f, 0.f, 0.f, 0.f};
#pragma unroll
      for (int q = 0; q < 4; ++q) ov += *(const f32x4*)(ORED + (q * 4 + t) * 512 + v4);
#pragma unroll
      for (int m = 0; m < 4; ++m) ov += *(const f32x4*)(VS + m * 512 + v4) * AS[t * 4 + m];
      float ss = (ov[0] * ov[0] + ov[1] * ov[1]) + (ov[2] * ov[2] + ov[3] * ov[3]); ss = wave_sum(ss);
      if (lane == 0) RED[wave] = ss;
      __syncthreads();
      const float tot = RED[2 * t] + RED[2 * t + 1]; const float rs = rsqrtf(tot * (1.0f / 512.0f) + EPS);
      const size_t row = row0 + t; const u32x2 rgw = *(const u32x2*)(Z + row * DINP + ZRG + h * 512 + v4); const f32x4 gn = *(const f32x4*)(a.gla_norm + v4);
      float r[4] = {bflo(rgw.x), bfhi(rgw.x), bflo(rgw.y), bfhi(rgw.y)}; float w[4];
#pragma unroll
      for (int e = 0; e < 4; ++e) w[e] = ov[e] * rs * gn[e] * (r[e] * sigmoidf_(r[e]));
      *(u32x2*)(OCAT + row * OC + 1024 + h * 512 + v4) = (u32x2){cvt_pk_bf16(w[0], w[1]), cvt_pk_bf16(w[2], w[3])}; }
    __syncthreads();
}

__device__ __forceinline__ void swa_sample_unit(const Args& a, unsigned char* lds, int unit, int tid) {
    const int lane = tid & 63, wave = tid >> 6;
    const int b = unit >> 2, kvh = unit & 3;
    float* KS = (float*)lds;
    float* VS = KS + 132 * 65;
    float* QS = VS + 132 * 64;
    float* PS = QS + 1024;
    const bf16_t* Z = (const bf16_t*)(a.ws + WS_Z); bf16_t* OCAT = (bf16_t*)(a.ws + WS_OCAT); const f32x2* ROPE = (const f32x2*)(a.ws + WS_ROPE);
    const size_t row0 = (size_t)MP + b * 4;
    for (int e = tid; e < 132 * 16; e += 512) { const int j = e >> 4, c = e & 15; f32x4 kv, vv;
        if (j < 128) { const size_t o = ((size_t)(b * 128 + j) * 4 + kvh) * 64 + c * 4; kv = *(const f32x4*)(a.ck + o); vv = *(const f32x4*)(a.cv + o); }
        else { const int i = j - 128; const bf16_t* kp = Z + (row0 + i) * DINP + ZKS + kvh * 64; const u32x2 kw = *(const u32x2*)(kp + c * 4); const u32x2 vw = *(const u32x2*)(Z + (row0 + i) * DINP + ZVS + kvh * 64 + c * 4);
            kv = (f32x4){bflo(kw.x), bfhi(kw.x), bflo(kw.y), bfhi(kw.y)}; vv = (f32x4){bflo(vw.x), bfhi(vw.x), bflo(vw.y), bfhi(vw.y)};
            if (c < 4) { const u32x2 pw = *(const u32x2*)(kp + (c ^ 2) * 4); const f32x4 pv = (f32x4){bflo(pw.x), bfhi(pw.x), bflo(pw.y), bfhi(pw.y)}; const float sg = c < 2 ? -1.f : 1.f;
                const f32x2* rp = ROPE + (2048 + i) * 8 + (c & 1) * 4;
#pragma unroll
                for (int d = 0; d < 4; ++d) { const f32x2 cs = rp[d]; kv[d] = kv[d] * cs.x + sg * pv[d] * cs.y; }
            } }
        float* kd = KS + j * 65 + c * 4; kd[0] = kv[0]; kd[1] = kv[1]; kd[2] = kv[2]; kd[3] = kv[3];
        *(f32x4*)(VS + j * 64 + c * 4) = vv;
        if (j >= 4) { const size_t o = ((size_t)(b * 128 + (j - 4)) * 4 + kvh) * 64 + c * 4; *(f32x4*)(a.out + OUT_KS + o) = kv; *(f32x4*)(a.out + OUT_VS + o) = vv; } }
    if (tid < 256) { const int pr = tid >> 4, c = tid & 15, g = pr >> 2, i = pr & 3; const bf16_t* qp = Z + (row0 + i) * DINP + ZQS + (kvh * 4 + g) * 64; const u32x2 qw = *(const u32x2*)(qp + c * 4);
        f32x4 qv = (f32x4){bflo(qw.x), bfhi(qw.x), bflo(qw.y), bfhi(qw.y)};
        if (c < 4) { const u32x2 pw = *(const u32x2*)(qp + (c ^ 2) * 4); const f32x4 pv = (f32x4){bflo(pw.x), bfhi(pw.x), bflo(pw.y), bfhi(pw.y)}; const float sg = c < 2 ? -1.f : 1.f;
            const f32x2* rp = ROPE + (2048 + i) * 8 + (c & 1) * 4;
#pragma unroll
            for (int d = 0; d < 4; ++d) { const f32x2 cs = rp[d]; qv[d] = qv[d] * cs.x + sg * pv[d] * cs.y; } }
        *(f32x4*)(QS + pr * 64 + c * 4) = qv * 0.125f; }
    __syncthreads();
    for (int pp = 0; pp < 2; ++pp) { const int pr = wave + pp * 8, g = pr >> 2, i = pr & 3; const float sk = a.sink[kvh * 4 + g];
        float s[3]; float mx = -3.0e38f;
#pragma unroll
        for (int jj = 0; jj < 3; ++jj) { const int j = lane + 64 * jj; float acc = 0.f;
            if (j < 132) {
#pragma unroll 16
                for (int d = 0; d < 64; ++d) acc += QS[pr * 64 + d] * KS[j * 65 + d]; }
            const bool ok = j < 132 && j > i && j <= i + 128; s[jj] = ok ? acc : -3.0e38f; mx = fmaxf(mx, s[jj]); }
        mx = fmaxf(wave_max(mx), sk); float sum = 0.f;
#pragma unroll
        for (int jj = 0; jj < 3; ++jj) { const int j = lane + 64 * jj; const bool ok = j < 132 && j > i && j <= i + 128; s[jj] = ok ? __expf(s[jj] - mx) : 0.f; sum += s[jj]; }
        sum = wave_sum(sum); const float inv = 1.f / (sum + __expf(sk - mx));
#pragma unroll
        for (int jj = 0; jj < 3; ++jj) { const int j = lane + 64 * jj; if (j < 132) PS[wave * 136 + j] = s[jj] * inv; }
        __syncthreads();
        float o = 0.f;
#pragma unroll 4
        for (int j = 0; j < 132; ++j) o += PS[wave * 136 + j] * VS[j * 64 + lane];
        OCAT[(row0 + i) * OC + (kvh * 4 + g) * 64 + lane] = f2bf(o);
        __syncthreads(); }
}


template <class Epi>
__device__ __forceinline__ void small_gemm_tile(unsigned char* lds, const bf16_t* A, int lda, const bf16_t* Bt, int ldb, int K, int kbreak, int rowbase, int tm, int tn, const Epi& E, int tid) {
    const int lane = tid & 63, wave = tid >> 6, r16 = lane & 15, q4 = lane >> 4, wm = wave >> 1, wn = wave & 1;
    unsigned char* AS = lds; unsigned char* BS = lds + 33792; float* RED = (float*)(lds + 67584);
    const bf16_t* Ag = A + (size_t)(rowbase + tm * 64) * lda; const bf16_t* Bg = Bt + (size_t)(tn * 64) * ldb;
    u32x4 ra[4], rb[4];
#define SG_LOAD(k0) do { _Pragma("unroll") for (int i_ = 0; i_ < 4; ++i_) { const int id_ = tid + i_ * 512, rr_ = id_ >> 5, cc_ = id_ & 31; \
        ra[i_] = *(const u32x4*)(Ag + (size_t)rr_ * lda + (k0) + cc_ * 8); rb[i_] = *(const u32x4*)(Bg + (size_t)rr_ * ldb + (k0) + cc_ * 8); } } while (0)
    f32x4 cur[2], first[2];
#pragma unroll
    for (int n_ = 0; n_ < 2; ++n_) { cur[n_] = (f32x4){0.f, 0.f, 0.f, 0.f}; first[n_] = (f32x4){0.f, 0.f, 0.f, 0.f}; }
    SG_LOAD(0);
    for (int k0 = 0; k0 < K; k0 += 256) {
#pragma unroll
        for (int i = 0; i < 4; ++i) { const int id = tid + i * 512, rr = id >> 5, cc = id & 31; *(u32x4*)(AS + rr * 528 + cc * 16) = ra[i]; *(u32x4*)(BS + rr * 528 + cc * 16) = rb[i]; }
        LBAR();
        if (k0 + 256 < K) SG_LOAD(k0 + 256);
        if (k0 == kbreak) {
#pragma unroll
            for (int n_ = 0; n_ < 2; ++n_) { first[n_] = cur[n_]; cur[n_] = (f32x4){0.f, 0.f, 0.f, 0.f}; } }
#pragma unroll
        for (int kk = 0; kk < 8; ++kk) { const bf16x8 af = *(const bf16x8*)(AS + (wm * 16 + r16) * 528 + kk * 64 + q4 * 16);
#pragma unroll
            for (int nt = 0; nt < 2; ++nt) { const bf16x8 bfg = *(const bf16x8*)(BS + (wn * 32 + nt * 16 + r16) * 528 + kk * 64 + q4 * 16); cur[nt] = __builtin_amdgcn_mfma_f32_16x16x32_bf16(bfg, af, cur[nt], 0, 0, 0); } }
        LBAR();
    }
    MFMA_SETTLE4(cur[0], cur[1], first[0], first[1]);
    const int row = rowbase + tm * 64 + wm * 16 + r16; float ssq = 0.f;
#pragma unroll
    for (int nt = 0; nt < 2; ++nt) ssq += E(cur[nt], first[nt], row, tn * 64 + wn * 32 + nt * 16 + q4 * 4);
    if (Epi::SUMSQ) { ssq += __shfl_xor(ssq, 16); ssq += __shfl_xor(ssq, 32);
        if (lane < 16) RED[wn * 64 + wm * 16 + r16] = ssq;
        __syncthreads();
        if (tid < 64) E.ss[(size_t)(rowbase + tm * 64 + tid) * 32 + tn] = RED[tid] + RED[64 + tid];
    }
    __syncthreads();
#undef SG_LOAD
}
struct SmAg {
    static constexpr bool SUMSQ = false;
    bf16_t* Z; const float* ss1; float* ss;
    __device__ __forceinline__ float operator()(const f32x4& a0, const f32x4&, int row, int col) const {
        if (col < DIN) { const float rs = 1.0f; *(u32x2*)(Z + (size_t)row * DINP + col) = (u32x2){cvt_pk_bf16(a0[0] * rs, a0[1] * rs), cvt_pk_bf16(a0[2] * rs, a0[3] * rs)}; }
        return 0.f; }
};
struct SmMergeA {
    static constexpr bool SUMSQ = false;
    const bf16_t* Z; float* T; float* ss;
    __device__ __forceinline__ float operator()(const f32x4& a0, const f32x4&, int row, int col) const {
        const u32x2 gs = *(const u32x2*)(Z + (size_t)row * DINP + ZGS + col); f32x4 o;
        o[0] = a0[0] * sigmoidf_(bflo(gs.x)); o[1] = a0[1] * sigmoidf_(bfhi(gs.x)); o[2] = a0[2] * sigmoidf_(bflo(gs.y)); o[3] = a0[3] * sigmoidf_(bfhi(gs.y));
        *(f32x4*)(T + (size_t)row * DM + col) = o; return 0.f; }
};
struct SmMergeB {
    static constexpr bool SUMSQ = false;
    const bf16_t* Z; const float* T; bf16_t* Y; float* ss;
    __device__ __forceinline__ float operator()(const f32x4& a0, const f32x4&, int row, int col) const {
        const u32x2 gg = *(const u32x2*)(Z + (size_t)row * DINP + ZGG + col); const f32x4 t = *(const f32x4*)(T + (size_t)row * DM + col); f32x4 o;
        o[0] = t[0] + a0[0] * sigmoidf_(bflo(gg.x)); o[1] = t[1] + a0[1] * sigmoidf_(bfhi(gg.x)); o[2] = t[2] + a0[2] * sigmoidf_(bflo(gg.y)); o[3] = t[3] + a0[3] * sigmoidf_(bfhi(gg.y));
        *(u32x2*)(Y + (size_t)row * DM + col) = (u32x2){cvt_pk_bf16(o[0], o[1]), cvt_pk_bf16(o[2], o[3])}; return 0.f; }
};
template <int MODE> struct SmResidB {
    static constexpr bool SUMSQ = true;
    const float* basef; const bf16_t* baseb; bf16_t* ob; float* ss;
    __device__ __forceinline__ float operator()(const f32x4& a0, const f32x4&, int row, int col) const {
        f32x4 o;
        if (MODE == 0) o = *(const f32x4*)(basef + (size_t)row * DM + col) + a0;
        else { const u32x2 w = *(const u32x2*)(baseb + (size_t)row * DM + col); o = (f32x4){bflo(w.x) + a0[0], bfhi(w.x) + a0[1], bflo(w.y) + a0[2], bfhi(w.y) + a0[3]}; }
        *(u32x2*)(ob + (size_t)row * DM + col) = (u32x2){cvt_pk_bf16(o[0], o[1]), cvt_pk_bf16(o[2], o[3])};
        return (o[0] * o[0] + o[1] * o[1]) + (o[2] * o[2] + o[3] * o[3]); }
};
template <bool WB> struct SmResid {
    static constexpr bool SUMSQ = true;
    const float* base; float* out; bf16_t* ob; float* ss;
    __device__ __forceinline__ float operator()(const f32x4& a0, const f32x4&, int row, int col) const {
        const f32x4 o = *(const f32x4*)(base + (size_t)row * DM + col) + a0; *(f32x4*)(out + (size_t)row * DM + col) = o;
        if (WB) *(u32x2*)(ob + (size_t)row * DM + col) = (u32x2){cvt_pk_bf16(o[0], o[1]), cvt_pk_bf16(o[2], o[3])};
        return (o[0] * o[0] + o[1] * o[1]) + (o[2] * o[2] + o[3] * o[3]); }
};

#define XB_TMO      128
#define XB_XCNT(j)  (256  + 64 * (j))
#define XB_XSUB(j)  (1280 + 64 * (j))
#define XB_XGEN(j)  (2304 + 64 * (j))
#define XB_TOP      3328
#define XB_TOPGEN   3392
#define XCD_BAR_WORDS 3456
#define XB_SPIN_CAP (1u << 18)

__device__ __forceinline__ unsigned xb_ld(unsigned* p)              { return __hip_atomic_load(p, __ATOMIC_RELAXED, __HIP_MEMORY_SCOPE_AGENT); }
__device__ __forceinline__ unsigned xb_add(unsigned* p, unsigned v) { return __hip_atomic_fetch_add(p, v, __ATOMIC_RELAXED, __HIP_MEMORY_SCOPE_AGENT); }
__device__ __forceinline__ unsigned xb_xcc_id() { return (unsigned)__builtin_amdgcn_s_getreg((3 << 11) | 20) & 0xFu; }
#define XB_SPIN(cond, bar) do { unsigned _sp = 0; while (cond) { __builtin_amdgcn_s_sleep(1); \
    if ((++_sp & 255u) == 0u) { if (xb_ld(&(bar)[XB_TMO])) break; if (_sp > XB_SPIN_CAP) { atomicAdd(&(bar)[XB_TMO], 1u); break; } } } } while (0)

struct XcdBarrier {
    unsigned* bar; unsigned x;
    volatile LAS unsigned* st;
};

__device__ __forceinline__ XcdBarrier xcd_barrier_post(unsigned* bar, volatile LAS unsigned* st) {
    XcdBarrier b; b.bar = bar; b.x = xb_xcc_id(); b.st = st;
    if (threadIdx.x == 0) (void)xb_add(&bar[XB_XCNT(b.x)], 1u);
    return b;
}
__device__ __forceinline__ void xcd_barrier_complete(unsigned* bar, unsigned x, unsigned& nloc, unsigned& nx) {
    const unsigned G = gridDim.x * gridDim.y * gridDim.z;
    unsigned sum, cnt, mine, sp = 0u;
    for (;;) {
        sum = 0u; cnt = 0u; mine = 0u;
#pragma unroll
        for (unsigned j = 0; j < 16; ++j) { const unsigned c = xb_ld(&bar[XB_XCNT(j)]); sum += c; cnt += (c > 0u) ? 1u : 0u; mine = (j == x) ? c : mine; }
        if (sum == G) break;
        __builtin_amdgcn_s_sleep(1);
        if ((++sp & 255u) == 0u) { if (xb_ld(&bar[XB_TMO])) break; if (sp > XB_SPIN_CAP) { atomicAdd(&bar[XB_TMO], 1u); break; } }
    }
    nloc = mine > 0u ? mine : 1u; nx = cnt > 0u ? cnt : 1u;
}

__device__ __forceinline__ void xcd_barrier(const XcdBarrier& b) {
    asm volatile("s_waitcnt vmcnt(0)" ::: "memory");
    __syncthreads();
    if (threadIdx.x == 0) {
        unsigned* bar = b.bar;
        __builtin_amdgcn_s_waitcnt(0);
        unsigned nloc = b.st[0], nx = b.st[1];
        if (nloc == 0u) { xcd_barrier_complete(bar, b.x, nloc, nx); b.st[0] = nloc; b.st[1] = nx; }
        const unsigned old = xb_add(&bar[XB_XSUB(b.x)], 1u);
        const unsigned gen = old / nloc;
        if (old + 1u == (gen + 1u) * nloc) {
            __builtin_amdgcn_fence(__ATOMIC_RELEASE, "agent");
            asm volatile("s_waitcnt vmcnt(0)" ::: "memory");
            const unsigned og = xb_add(&bar[XB_TOP], 1u);
            const unsigned tg = og / nx;
            if (og + 1u == (tg + 1u) * nx) xb_add(&bar[XB_TOPGEN], 1u);
            else XB_SPIN(xb_ld(&bar[XB_TOPGEN]) == tg, bar);
            __builtin_amdgcn_fence(__ATOMIC_ACQUIRE, "agent");
            xb_add(&bar[XB_XGEN(b.x)], 1u);
            asm volatile("s_waitcnt vmcnt(0)" ::: "memory");
        } else {
            XB_SPIN(xb_ld(&bar[XB_XGEN(b.x)]) == gen, bar);
            __builtin_amdgcn_fence(__ATOMIC_ACQUIRE, "agent");
            asm volatile("s_waitcnt vmcnt(0)" ::: "memory");
        }
    }
    __syncthreads();
}


__global__ void __launch_bounds__(512, 2) hybrid_fwd(Args a) {
    extern __shared__ __attribute__((aligned(16))) unsigned char lds[];
    cg::grid_group grid = cg::this_grid();
    const int tid = threadIdx.x, lane = tid & 63, wave = tid >> 6, G = gridDim.x, bx = blockIdx.x;
    const int vcu = (G % 8 == 0) ? (bx % 8) * (G / 8) + bx / 8 : bx;
    const int gw = bx * 8 + wave, NGW = G * 8;
    unsigned char* ws = a.ws;
    bf16_t* WIN = (bf16_t*)(ws + WS_WIN); bf16_t* PCAT = (bf16_t*)(ws + WS_PCAT); bf16_t* WO = (bf16_t*)(ws + WS_WO); bf16_t* WUP = (bf16_t*)(ws + WS_WUP); bf16_t* WDN = (bf16_t*)(ws + WS_WDN);
    bf16_t* XB = (bf16_t*)(ws + WS_XB); bf16_t* Z = (bf16_t*)(ws + WS_Z); bf16_t* HID = (bf16_t*)(ws + WS_Z); bf16_t* OCAT = (bf16_t*)(ws + WS_OCAT); bf16_t* Y = (bf16_t*)(ws + WS_Y); bf16_t* X1B = (bf16_t*)(ws + WS_X1B);
    float* SS1 = (float*)(ws + WS_SS1); float* SS2 = (float*)(ws + WS_SS2P); float* SSF = (float*)(ws + WS_SSFP); float* GSS = (float*)(ws + WS_GSSP);
    LAS unsigned char* ldsl = (LAS unsigned char*)lds;
    const int lo = a.ph_lo, hi = a.ph_hi;
    volatile LAS unsigned* MISC = (volatile LAS unsigned*)(ldsl + LDS_BYTES - 64);
    if (tid < 2) MISC[tid] = 0u;
    __syncthreads();
    XcdBarrier xbar = xcd_barrier_post((unsigned*)(ws + WS_BAR), MISC);
#define IN(k) (lo <= (k) && (k) < hi)
#define SEAM(k) do { if (IN(k) && IN((k) + 1)) { if ((k) == 0) grid.sync(); else xcd_barrier(xbar); } } while (0)

    if (IN(0)) { phase0(a, lds, tid); } SEAM(0);
    if (IN(1)) { for (int t = bx; t < 264; t += G) { SmAg E{Z, SS1, nullptr}; small_gemm_tile<SmAg>(lds, XB, DM, WIN, DM, DM, -1, 0, t, 184, E, tid); }
        pg8::Gemm g{XB, WIN, M, ZAG, DM, DM, DM}; pg8::StaticOrder S; S.init(M, ZAG, G, bx);
        pg8::EpiScaleBf16<0> E{Z, DINP, SS1}; pg8::gemm_phase<pg8::EpiScaleBf16<0>, pg8::StaticOrder>(ldsl, g, S, E); } SEAM(1);
    if (IN(2)) {
        { const int per = (2048 + G - 1) / G; const int f = vcu * per; const int cnt = f >= 2048 ? 0 : (2048 - f < per ? 2048 - f : per); gla_pre_items(a, lds, f, cnt, tid); }
        for (int u = bx; u < 512; u += G) swa_prompt_unit(a, lds, u, tid);
        for (int u = bx; u < 512; u += G) gla_sample_unit(a, lds, u, tid);
        for (int u = bx; u < 512; u += G) swa_sample_unit(a, lds, u, tid);
        xcd_barrier(xbar);
        for (int u = vcu; u < 256; u += G) gla_prompt_unit(a, lds, u, tid);
    } SEAM(2);
    if (IN(3)) {
        for (int t = bx; t < 256; t += G) { SmMergeA E{Z, a.out, nullptr}; small_gemm_tile<SmMergeA>(lds, OCAT, OC, PCAT, OC, 1024, -1, MP, t >> 5, t & 31, E, tid); }
        for (int t = bx; t < 256; t += G) { SmMergeB E{Z, a.out, Y, nullptr}; small_gemm_tile<SmMergeB>(lds, OCAT + 1024, OC, PCAT + 1024, OC, 2048, -1, MP, t >> 5, t & 31, E, tid); }
        for (int it0 = gw; it0 < MP * 4; it0 += 4 * NGW) {
            u32x4 ow[4], rw[4]; float gp[4];
#pragma unroll
            for (int u = 0; u < 4; ++u) { const int it = it0 + u * NGW; const int row = it >> 2, h = it & 3;
                ow[u] = *(const u32x4*)(OCAT + (size_t)row * OC + 1024 + h * 512 + lane * 8); rw[u] = *(const u32x4*)(Z + (size_t)row * DINP + ZRG + h * 512 + lane * 8);
                gp[u] = lane < 32 ? GSS[(size_t)it * 32 + lane] : 0.f; }
            const f32x4 g0 = *(const f32x4*)(a.gla_norm + lane * 8), g1 = *(const f32x4*)(a.gla_norm + lane * 8 + 4);
            const float gn[8] = {g0[0], g0[1], g0[2], g0[3], g1[0], g1[1], g1[2], g1[3]};
#pragma unroll
            for (int u = 0; u < 4; ++u) { const int it = it0 + u * NGW; const int row = it >> 2, h = it & 3; const float rs = rsqrtf(wave_sum(gp[u]) * (1.0f / 512.0f) + EPS);
                float o[8] = {bflo(ow[u].x), bfhi(ow[u].x), bflo(ow[u].y), bfhi(ow[u].y), bflo(ow[u].z), bfhi(ow[u].z), bflo(ow[u].w), bfhi(ow[u].w)};
                float r[8] = {bflo(rw[u].x), bfhi(rw[u].x), bflo(rw[u].y), bfhi(rw[u].y), bflo(rw[u].z), bfhi(rw[u].z), bflo(rw[u].w), bfhi(rw[u].w)};
#pragma unroll
                for (int e = 0; e < 8; ++e) o[e] = o[e] * rs * gn[e] * (r[e] * sigmoidf_(r[e]));
                *(u32x4*)(OCAT + (size_t)row * OC + 1024 + h * 512 + lane * 8) = (u32x4){cvt_pk_bf16(o[0], o[1]), cvt_pk_bf16(o[2], o[3]), cvt_pk_bf16(o[4], o[5]), cvt_pk_bf16(o[6], o[7])}; } }
    } SEAM(3);
    if (IN(4)) {
        { pg8::Gemm g{OCAT, PCAT, MP, DM, 1024, OC, OC}; pg8::StaticOrder S; S.init(MP, DM, G, bx);
          pg8::EpiMergeA E{(bf16_t*)a.out, Z + ZGS, DINP}; pg8::gemm_phase<pg8::EpiMergeA, pg8::StaticOrder>(ldsl, g, S, E); }
        { pg8::Gemm g{OCAT + 1024, PCAT + 1024, MP, DM, 2048, OC, OC}; pg8::StaticOrder S; S.init(MP, DM, G, bx);
          pg8::EpiMergeB E{(const bf16_t*)a.out, Z + ZGG, DINP, Y}; pg8::gemm_phase<pg8::EpiMergeB, pg8::StaticOrder>(ldsl, g, S, E); }
    } SEAM(4);
    if (IN(5)) {
        for (int t = bx; t < 256; t += G) { SmResidB<0> E{a.xs - (size_t)MP * DM, nullptr, X1B, SS2}; small_gemm_tile<SmResidB<0>>(lds, Y, DM, WO, DM, DM, -1, MP, t >> 5, t & 31, E, tid); }
        { pg8::Gemm g{Y, WO, MP, DM, DM, DM, DM}; pg8::StaticOrder S; S.init(MP, DM, G, bx);
          pg8::EpiResidB<0> E{a.xp, a.xs, nullptr, X1B, SS2}; pg8::gemm_phase<pg8::EpiResidB<0>, pg8::StaticOrder>(ldsl, g, S, E); }
    } SEAM(5);
    if (IN(6)) {
        for (int m = gw; m < M; m += NGW) { const float t_ = wave_sum(lane < 32 ? SS2[(size_t)m * 32 + lane] : 0.f); if (lane == 0) SS1[m] = rsqrtf(t_ * (1.0f / DM) + EPS); }
        xcd_barrier(xbar);
        pg8::Gemm g{X1B, WUP, M, DFF, DM, DM, DM}; pg8::StaticOrder S; S.init(M, DFF, G, bx);
        pg8::EpiScaleBf16<1> E{HID, DFF, SS1}; pg8::gemm_phase<pg8::EpiScaleBf16<1>, pg8::StaticOrder>(ldsl, g, S, E); } SEAM(6);
    if (IN(7)) {
        for (int t = bx; t < 256; t += G) { SmResidB<1> E{nullptr, X1B, Y, SSF}; small_gemm_tile<SmResidB<1>>(lds, HID, DFF, WDN, DFF, DFF, -1, MP, t >> 5, t & 31, E, tid); }
        { pg8::Gemm g{HID, WDN, MP, DM, DFF, DFF, DFF}; pg8::StaticOrder S; S.init(MP, DM, G, bx);
          pg8::EpiResidB<1> E{nullptr, nullptr, X1B, Y, SSF}; pg8::gemm_phase<pg8::EpiResidB<1>, pg8::StaticOrder>(ldsl, g, S, E); }
    } SEAM(7);
    if (IN(8)) {
        for (int m = gw; m < M; m += NGW) { const float sf_ = wave_sum(lane < 32 ? SSF[(size_t)m * 32 + lane] : 0.f); const float rs = rsqrtf(sf_ * (1.0f / DM) + EPS);
            const u32x4* xb = (const u32x4*)(Y + (size_t)m * DM); f32x4* yr = (f32x4*)(a.out + (size_t)m * DM); u32x4 xw[4];
#pragma unroll
            for (int j = 0; j < 4; ++j) xw[j] = xb[lane + 64 * j];
#pragma unroll
            for (int j = 0; j < 4; ++j) { float f[8]; pg8::unpack8(xw[j], f); const int c = (lane + 64 * j) * 8; const f32x4 w0 = *(const f32x4*)(a.fnorm + c), w1 = *(const f32x4*)(a.fnorm + c + 4);
                yr[(lane + 64 * j) * 2] = (f32x4){f[0] * rs * w0[0], f[1] * rs * w0[1], f[2] * rs * w0[2], f[3] * rs * w0[3]}; yr[(lane + 64 * j) * 2 + 1] = (f32x4){f[4] * rs * w1[0], f[5] * rs * w1[1], f[6] * rs * w1[2], f[7] * rs * w1[3]}; } }
    }
#undef IN
#undef SEAM
}

#ifndef N_LAUNCHES
#define N_LAUNCHES 1
#endif
extern "C" void kernel_launch(void* const* d_in, const int* in_sizes, int n_in, void* d_out, int out_size, void* d_ws, size_t ws_size, hipStream_t stream) {
    static int grid = 0;
    if (grid == 0) {
        if (n_in != 18 || (size_t)out_size != OUT_END || ws_size < WS_END) { fprintf(stderr, "kernel_launch: unexpected shapes (n_in %d, out %d, ws %zu)\n", n_in, out_size, ws_size); grid = -1; return; }
        int dev = 0, cus = 0, per_cu = 0;
        hipGetDevice(&dev); hipDeviceGetAttribute(&cus, hipDeviceAttributeMultiprocessorCount, dev);
        hipFuncSetAttribute((const void*)hybrid_fwd, hipFuncAttributeMaxDynamicSharedMemorySize, LDS_BYTES);
        hipOccupancyMaxActiveBlocksPerMultiprocessor(&per_cu, (const void*)hybrid_fwd, 512, LDS_BYTES);
        if (per_cu < 1) { fprintf(stderr, "kernel_launch: occupancy query says %d blocks per CU\n", per_cu); grid = -1; return; }
        grid = cus;
    }
    if (grid < 0) return;
    Args a{};
    a.xp = (const float*)d_in[0]; a.xs = (const float*)d_in[1]; a.ck = (const float*)d_in[2]; a.cv = (const float*)d_in[3]; a.s0 = (const float*)d_in[4];
    a.norm1 = (const float*)d_in[5]; a.w_in = (const float*)d_in[6]; a.w_a2 = (const float*)d_in[7]; a.b_a = (const float*)d_in[8]; a.sink = (const float*)d_in[9];
    a.gla_norm = (const float*)d_in[10]; a.p_swa = (const float*)d_in[11]; a.p_gla = (const float*)d_in[12]; a.w_o = (const float*)d_in[13]; a.norm2 = (const float*)d_in[14];
    a.w_up = (const float*)d_in[15]; a.w_down = (const float*)d_in[16]; a.fnorm = (const float*)d_in[17];
    a.out = (float*)d_out; a.ws = (unsigned char*)d_ws;
    if (hipMemsetAsync((char*)d_ws + WS_BAR, 0, BAR_BYTES, stream) != hipSuccess) { fprintf(stderr, "kernel_launch: hipMemsetAsync failed\n"); return; }
    for (int li = 0; li < N_LAUNCHES; ++li) {
        a.ph_lo = (N_LAUNCHES == 1) ? 0 : li; a.ph_hi = (N_LAUNCHES == 1) ? NPHASE : li + 1;
        void* args[] = {&a};
        hipError_t e = hipLaunchCooperativeKernel((const void*)hybrid_fwd, dim3(grid), dim3(512), args, LDS_BYTES, stream);
        if (e != hipSuccess) { fprintf(stderr, "kernel_launch: cooperative launch %d failed: %s (grid %d)\n", li, hipGetErrorString(e), grid); break; }
    }
}
```
